# Optimizing an MI355X kernel written in HIP

```python
import math
import jax, jax.numpy as jnp
from jax import lax
import numpy as np

D_MODEL = 1024
BATCH = 1
SEQ = 16384
DEPTH = 2

GRID_W = 64
CTX_LEN = 256
BLOCK_Q = 128
RET_CHUNK = 128
ROPE_THETA = 10000.0
EPS = 1e-6

RET_HEADS = 8
RET_HEAD_DIM = 64
GQA_HEADS = 8
GQA_KV_HEADS = 2
GQA_HEAD_DIM = 64
GQA_GROUP = GQA_HEADS // GQA_KV_HEADS
MLA_HEADS = 8
MLA_Q_RANK = 384
MLA_KV_RANK = 256
MLA_NOPE = 64
MLA_ROPE = 32
MLA_V = 64
FFN_DIM = 2816
N_EXPERTS = 8
TOP_K = 2
EXPERT_DIM = 3584

RET_W = RET_HEADS * RET_HEAD_DIM
GQA_QW = GQA_HEADS * GQA_HEAD_DIM
GQA_KW = GQA_KV_HEADS * GQA_HEAD_DIM
L0_WIDTHS = (RET_W, RET_W, RET_W, RET_W, GQA_QW, GQA_KW, GQA_KW)
L0_IN = sum(L0_WIDTHS)
L0_SPLITS = tuple(int(v) for v in np.cumsum(L0_WIDTHS)[:-1])
L1_WIDTHS = (MLA_Q_RANK, MLA_KV_RANK, MLA_ROPE)
L1_IN = sum(L1_WIDTHS)
L1_SPLITS = tuple(int(v) for v in np.cumsum(L1_WIDTHS)[:-1])

kernel_name = "hybrid_retention_gqa_mla_moe_dit"


def rms_norm(x, g):
    xf = x.astype(jnp.float32)
    y = xf * lax.rsqrt(jnp.mean(xf * xf, axis=-1, keepdims=True) + EPS)
    return (y * g.astype(jnp.float32)).astype(x.dtype)


def modulate(x, g, shift, scale):
    return rms_norm(x, g) * (1 + scale) + shift


def ada_params(cvec, w, b):
    mod = jax.nn.silu(cvec) @ w + b
    return jnp.split(mod[..., None, :], 6, axis=-1)


def axial_rope_tables(n, rot_dim):
    rows = n // GRID_W
    row = jnp.broadcast_to(jnp.arange(rows)[:, None], (rows, GRID_W)).reshape(n).astype(jnp.float32)
    col = jnp.broadcast_to(jnp.arange(GRID_W)[None, :], (rows, GRID_W)).reshape(n).astype(jnp.float32)
    axis_dim = rot_dim // 2
    inv_freq = ROPE_THETA ** (-jnp.arange(0, axis_dim, 2, dtype=jnp.float32) / axis_dim)
    ang = jnp.concatenate([row[:, None] * inv_freq, col[:, None] * inv_freq], axis=-1)
    return jnp.cos(ang), jnp.sin(ang)


def apply_rope(x, cos, sin):
    xf = x.astype(jnp.float32).reshape(x.shape[:-1] + (x.shape[-1] // 2, 2))
    x0, x1 = xf[..., 0], xf[..., 1]
    c = cos[None, :, None, :]
    s = sin[None, :, None, :]
    out = jnp.stack([x0 * c - x1 * s, x0 * s + x1 * c], axis=-1).reshape(x.shape)
    return out.astype(x.dtype)


def block_attention(q, k, v):
    b, n, hk, g, dq = q.shape
    nb = n // BLOCK_Q
    scale = dq ** -0.5
    qb = q.reshape(b, nb, BLOCK_Q, hk, g, dq).transpose(1, 0, 2, 3, 4, 5)

    def one_block(qblk):
        s = jnp.einsum("bqkgd,bskd->bkgqs", qblk, k, preferred_element_type=jnp.float32) * scale
        p = jax.nn.softmax(s, axis=-1).astype(v.dtype)
        return jnp.einsum("bkgqs,bskd->bqkgd", p, v)

    out = lax.map(one_block, qb)
    return out.transpose(1, 0, 2, 3, 4, 5).reshape(b, n, hk, g, v.shape[-1])


def retention_scan(q, k, v, log_gamma, s0):
    b, n, h, d = q.shape
    C = RET_CHUNK
    nc = n // C
    f32 = jnp.float32
    qf = q.astype(f32).reshape(b, nc, C, h, d)
    kf = k.astype(f32).reshape(b, nc, C, h, d)
    vf = v.astype(f32).reshape(b, nc, C, h, d)
    lg = log_gamma.astype(f32)
    idx = jnp.arange(C, dtype=f32)
    rel = idx[:, None] - idx[None, :]
    decay = jnp.where(rel[None] >= 0, jnp.exp(jnp.maximum(rel, 0.0)[None] * lg[:, None, None]), 0.0)
    scores = jnp.einsum("bnchd,bnmhd->bnhcm", qf, kf) * decay[None, None]
    o_inner = jnp.einsum("bnhcm,bnmhe->bnche", scores, vf)
    zeta = jnp.exp((C - 1 - idx)[:, None] * lg[None, :])
    xi = jnp.exp((idx + 1)[:, None] * lg[None, :])
    u = jnp.einsum("bnmhd,bnmhe->nbhde", kf * zeta[None, None, :, :, None], vf)
    g_chunk = jnp.exp(C * lg)[None, :, None, None]

    def step(s, u_n):
        return g_chunk * s + u_n, s

    s_final, s_prev = lax.scan(step, s0, u)
    o_cross = jnp.einsum("bnchd,nbhde->bnche", qf * xi[None, None, :, :, None], s_prev)
    return (o_inner + o_cross).reshape(b, n, h, d), s_final


def bidir_retention(q, k, v, log_decay, s0_fwd, s0_bwd):
    o_f, s_f = retention_scan(q, k, v, log_decay[0], s0_fwd)
    o_b, s_b = retention_scan(q[:, ::-1], k[:, ::-1], v[:, ::-1], log_decay[1], s0_bwd)
    return o_f + o_b[:, ::-1], s_f, s_b


def head_group_norm(o):
    mu = jnp.mean(o, axis=-1, keepdims=True)
    var = jnp.mean(jnp.square(o - mu), axis=-1, keepdims=True)
    return (o - mu) * lax.rsqrt(var + EPS)


def swiglu(h, w1, w3, w2):
    return (jax.nn.silu(h @ w1) * (h @ w3)) @ w2


def even_project(h, w_in, qn_g, kn_g):
    b, n, _ = h.shape
    a_q, a_k, a_v, a_g, b_q, b_k, b_v = jnp.split(h @ w_in, L0_SPLITS, axis=-1)
    rq = a_q.reshape(b, n, RET_HEADS, RET_HEAD_DIM)
    rk = a_k.reshape(b, n, RET_HEADS, RET_HEAD_DIM) * (RET_HEAD_DIM ** -0.5)
    rv = a_v.reshape(b, n, RET_HEADS, RET_HEAD_DIM)
    aq = rms_norm(b_q.reshape(b, n, GQA_HEADS, GQA_HEAD_DIM), qn_g)
    ak = rms_norm(b_k.reshape(b, n, GQA_KV_HEADS, GQA_HEAD_DIM), kn_g)
    av = b_v.reshape(b, n, GQA_KV_HEADS, GQA_HEAD_DIM)
    return rq, rk, rv, a_g, aq, ak, av


def retention_out(o, gate, dtype):
    b, n = o.shape[:2]
    return (head_group_norm(o).reshape(b, n, RET_W) * jax.nn.silu(gate.astype(jnp.float32))).astype(dtype)


def even_layer(x, ctx, c, c_ctx, ada_w, ada_b, n1_g, n2_g, w_in, log_decay, qn_g, kn_g, w_out,
               w1, w3, w2, cos, sin):
    b, n, _ = x.shape
    lc = ctx.shape[1]
    mx = ada_params(c, ada_w, ada_b)
    mc = ada_params(c_ctx, ada_w, ada_b)
    rq_c, rk_c, rv_c, rg_c, aq_c, ak_c, av_c = even_project(modulate(ctx, n1_g, mc[0], mc[1]), w_in, qn_g, kn_g)
    rq_x, rk_x, rv_x, rg_x, aq_x, ak_x, av_x = even_project(modulate(x, n1_g, mx[0], mx[1]), w_in, qn_g, kn_g)
    zero = jnp.zeros((b, RET_HEADS, RET_HEAD_DIM, RET_HEAD_DIM), jnp.float32)
    ro_c, s_f, s_b = bidir_retention(rq_c, rk_c, rv_c, log_decay, zero, zero)
    ro_x, _, _ = bidir_retention(rq_x, rk_x, rv_x, log_decay, s_f, s_b)
    ra_c = retention_out(ro_c, rg_c, ctx.dtype)
    ra_x = retention_out(ro_x, rg_x, x.dtype)
    aq_x = apply_rope(aq_x, cos, sin)
    ak_x = apply_rope(ak_x, cos, sin)
    k_all = jnp.concatenate([ak_x, ak_c], axis=1)
    v_all = jnp.concatenate([av_x, av_c], axis=1)
    ao_x = block_attention(aq_x.reshape(b, n, GQA_KV_HEADS, GQA_GROUP, GQA_HEAD_DIM), k_all, v_all).reshape(b, n, GQA_QW)
    ao_c = block_attention(aq_c.reshape(b, lc, GQA_KV_HEADS, GQA_GROUP, GQA_HEAD_DIM), ak_c, av_c).reshape(b, lc, GQA_QW)
    x = x + mx[2] * (jnp.concatenate([ra_x, ao_x], axis=-1) @ w_out)
    ctx = ctx + mc[2] * (jnp.concatenate([ra_c, ao_c], axis=-1) @ w_out)
    x = x + mx[5] * swiglu(modulate(x, n2_g, mx[3], mx[4]), w1, w3, w2)
    ctx = ctx + mc[5] * swiglu(modulate(ctx, n2_g, mc[3], mc[4]), w1, w3, w2)
    return x, ctx


def mla_keys(ckv, kr, kv_lora_g, w_ukv, kn_g, kr_g, rope):
    b, n, _ = ckv.shape
    kv = (rms_norm(ckv, kv_lora_g) @ w_ukv).reshape(b, n, MLA_HEADS, MLA_NOPE + MLA_V)
    k_nope = rms_norm(kv[..., :MLA_NOPE], kn_g)
    k_rope = rms_norm(kr.reshape(b, n, 1, MLA_ROPE), kr_g)
    if rope is not None:
        k_rope = apply_rope(k_rope, rope[0], rope[1])
    k = jnp.concatenate([k_nope, jnp.broadcast_to(k_rope, (b, n, MLA_HEADS, MLA_ROPE))], axis=-1)
    return k, kv[..., MLA_NOPE:]


def moe_swiglu(h, router, e_w1, e_w3, e_w2):
    b, n, d = h.shape
    t = h.reshape(b * n, d)
    logits = jnp.einsum("td,de->te", t, router, preferred_element_type=jnp.float32)
    top_v, top_i = lax.top_k(logits, TOP_K)
    top_w = jax.nn.softmax(top_v, axis=-1)
    gates = jnp.sum(jax.nn.one_hot(top_i, N_EXPERTS, dtype=jnp.float32) * top_w[..., None], axis=1)
    out = jnp.zeros((b * n, d), jnp.float32)
    for e in range(N_EXPERTS):
        out = out + gates[:, e:e + 1] * swiglu(t, e_w1[e], e_w3[e], e_w2[e]).astype(jnp.float32)
    return out.reshape(b, n, d).astype(h.dtype)


def odd_layer(x, ctx, c, c_ctx, ada_w, ada_b, n1_g, n2_g, w_in, q_lora_g, kv_lora_g, w_uq, w_ukv,
              qn_g, qr_g, kn_g, kr_g, w_out, router, e_w1, e_w3, e_w2, cos, sin):
    b, n, _ = x.shape
    mx = ada_params(c, ada_w, ada_b)
    mc = ada_params(c_ctx, ada_w, ada_b)
    cq_x, ckv_x, kr_x = jnp.split(modulate(x, n1_g, mx[0], mx[1]) @ w_in, L1_SPLITS, axis=-1)
    ckv_c, kr_c = jnp.split(modulate(ctx, n1_g, mc[0], mc[1]) @ w_in[:, MLA_Q_RANK:], (MLA_KV_RANK,), axis=-1)
    q = (rms_norm(cq_x, q_lora_g) @ w_uq).reshape(b, n, MLA_HEADS, MLA_NOPE + MLA_ROPE)
    q = jnp.concatenate([rms_norm(q[..., :MLA_NOPE], qn_g),
                         apply_rope(rms_norm(q[..., MLA_NOPE:], qr_g), cos, sin)], axis=-1)
    k_x, v_x = mla_keys(ckv_x, kr_x, kv_lora_g, w_ukv, kn_g, kr_g, (cos, sin))
    k_c, v_c = mla_keys(ckv_c, kr_c, kv_lora_g, w_ukv, kn_g, kr_g, None)
    o = block_attention(q[:, :, :, None, :], jnp.concatenate([k_x, k_c], axis=1),
                        jnp.concatenate([v_x, v_c], axis=1)).reshape(b, n, MLA_HEADS * MLA_V)
    x = x + mx[2] * (o @ w_out)
    x = x + mx[5] * moe_swiglu(modulate(x, n2_g, mx[3], mx[4]), router, e_w1, e_w3, e_w2)
    return x


def setup_inputs(seed: int = 0) -> dict:
    key = jax.random.key(seed)
    ks = iter(jax.random.split(key, 48))
    D = D_MODEL

    def nrm(shape, scale):
        return jax.random.normal(next(ks), shape, jnp.float32) * scale

    def gain(m):
        return 1.0 + nrm((m,), 0.02)

    base_log_decay = jnp.log1p(-(2.0 ** (-5.0 - jnp.arange(RET_HEADS, dtype=jnp.float32))))
    return {
        "x": nrm((BATCH, SEQ, D), 1.0),
        "c": nrm((BATCH, D), 1.0),
        "ctx": nrm((BATCH, CTX_LEN, D), 1.0),
        "c_ctx": nrm((D,), 1.0),
        "l0_ada_w": nrm((D, 6 * D), 0.5 * D ** -0.5),
        "l0_ada_b": nrm((6 * D,), 0.01),
        "l0_norm1_g": gain(D),
        "l0_norm2_g": gain(D),
        "l0_w_in": nrm((D, L0_IN), D ** -0.5),
        "l0_ret_log_decay": base_log_decay[None, :] * jnp.exp(nrm((2, RET_HEADS), 0.05)),
        "l0_q_norm_g": gain(GQA_HEAD_DIM),
        "l0_k_norm_g": gain(GQA_HEAD_DIM),
        "l0_w_out": nrm((RET_W + GQA_QW, D), (RET_W + GQA_QW) ** -0.5),
        "l0_ffn_w1": nrm((D, FFN_DIM), D ** -0.5),
        "l0_ffn_w3": nrm((D, FFN_DIM), D ** -0.5),
        "l0_ffn_w2": nrm((FFN_DIM, D), FFN_DIM ** -0.5),
        "l1_ada_w": nrm((D, 6 * D), 0.5 * D ** -0.5),
        "l1_ada_b": nrm((6 * D,), 0.01),
        "l1_norm1_g": gain(D),
        "l1_norm2_g": gain(D),
        "l1_w_in": nrm((D, L1_IN), D ** -0.5),
        "l1_q_lora_g": gain(MLA_Q_RANK),
        "l1_kv_lora_g": gain(MLA_KV_RANK),
        "l1_w_uq": nrm((MLA_Q_RANK, MLA_HEADS * (MLA_NOPE + MLA_ROPE)), MLA_Q_RANK ** -0.5),
        "l1_w_ukv": nrm((MLA_KV_RANK, MLA_HEADS * (MLA_NOPE + MLA_V)), MLA_KV_RANK ** -0.5),
        "l1_q_nope_g": gain(MLA_NOPE),
        "l1_q_rope_g": gain(MLA_ROPE),
        "l1_k_nope_g": gain(MLA_NOPE),
        "l1_k_rope_g": gain(MLA_ROPE),
        "l1_w_out": nrm((MLA_HEADS * MLA_V, D), (MLA_HEADS * MLA_V) ** -0.5),
        "l1_router": nrm((D, N_EXPERTS), D ** -0.5),
        "l1_exp_w1": nrm((N_EXPERTS, D, EXPERT_DIM), D ** -0.5),
        "l1_exp_w3": nrm((N_EXPERTS, D, EXPERT_DIM), D ** -0.5),
        "l1_exp_w2": nrm((N_EXPERTS, EXPERT_DIM, D), EXPERT_DIM ** -0.5),
    }


def reference(x, c, ctx, c_ctx, l0_ada_w, l0_ada_b, l0_norm1_g, l0_norm2_g, l0_w_in, l0_ret_log_decay,
              l0_q_norm_g, l0_k_norm_g, l0_w_out, l0_ffn_w1, l0_ffn_w3, l0_ffn_w2,
              l1_ada_w, l1_ada_b, l1_norm1_g, l1_norm2_g, l1_w_in, l1_q_lora_g, l1_kv_lora_g,
              l1_w_uq, l1_w_ukv, l1_q_nope_g, l1_q_rope_g, l1_k_nope_g, l1_k_rope_g, l1_w_out,
              l1_router, l1_exp_w1, l1_exp_w3, l1_exp_w2):
    n = x.shape[1]
    cos_b, sin_b = axial_rope_tables(n, GQA_HEAD_DIM)
    cos_m, sin_m = axial_rope_tables(n, MLA_ROPE)
    for layer in range(DEPTH):
        if layer % 2 == 0:
            x, ctx = even_layer(x, ctx, c, c_ctx, l0_ada_w, l0_ada_b, l0_norm1_g, l0_norm2_g, l0_w_in,
                                l0_ret_log_decay, l0_q_norm_g, l0_k_norm_g, l0_w_out,
                                l0_ffn_w1, l0_ffn_w3, l0_ffn_w2, cos_b, sin_b)
        else:
            x = odd_layer(x, ctx, c, c_ctx, l1_ada_w, l1_ada_b, l1_norm1_g, l1_norm2_g, l1_w_in,
                          l1_q_lora_g, l1_kv_lora_g, l1_w_uq, l1_w_ukv, l1_q_nope_g, l1_q_rope_g,
                          l1_k_nope_g, l1_k_rope_g, l1_w_out, l1_router, l1_exp_w1, l1_exp_w3,
                          l1_exp_w2, cos_m, sin_m)
    return x
```

```cpp
#include <hip/hip_runtime.h>
#include <stdint.h>
#include <stdio.h>
#include <math.h>
#define LAS __attribute__((address_space(3)))
#define GAS __attribute__((address_space(1)))
typedef unsigned short bf16_t;
typedef short bf16x8 __attribute__((ext_vector_type(8)));
typedef short s16x4 __attribute__((ext_vector_type(4)));
typedef float f32x2 __attribute__((ext_vector_type(2)));
typedef float f32x4 __attribute__((ext_vector_type(4)));
typedef float f32x16 __attribute__((ext_vector_type(16)));
typedef unsigned u32x2 __attribute__((ext_vector_type(2)));
typedef unsigned u32x4 __attribute__((ext_vector_type(4)));
typedef __bf16 bf16x2_t __attribute__((ext_vector_type(2)));
typedef int v8i32 __attribute__((ext_vector_type(8)));
__device__ __forceinline__ unsigned pk4_fp8(float a, float b, float cc, float d) { int p = __builtin_amdgcn_cvt_pk_fp8_f32(a, b, 0, false); p = __builtin_amdgcn_cvt_pk_fp8_f32(cc, d, p, true); return (unsigned)p; }

__device__ __forceinline__ unsigned pk2(float lo, float hi) { f32x2 v = {lo, hi}; bf16x2_t b = __builtin_convertvector(v, bf16x2_t); return __builtin_bit_cast(unsigned, b); }
__device__ __forceinline__ float bflo(unsigned w) { return __uint_as_float(w << 16); }
__device__ __forceinline__ float bfhi(unsigned w) { return __uint_as_float(w & 0xffff0000u); }
__device__ __forceinline__ float fexp2(float x) { return __builtin_amdgcn_exp2f(x); }
__device__ __forceinline__ float frcp(float x) { return __builtin_amdgcn_rcpf(x); }
__device__ __forceinline__ float fsilu(float x) { return x * frcp(1.f + fexp2(-1.4426950408889634f * x)); }
__device__ __forceinline__ float wsum(float v) {
#pragma unroll
    for (int o = 32; o >= 1; o >>= 1) v += __shfl_xor(v, o);
    return v;
}
__device__ __forceinline__ float xhalf(float v) { return __shfl_xor(v, 32); }
__device__ __forceinline__ int crow(int r, int hi) { return (r & 3) + 8 * (r >> 2) + 4 * hi; }
typedef short v4i16_t __attribute__((ext_vector_type(4)));
__device__ __forceinline__ s16x4 ldtr(LAS const unsigned char* p) { return __builtin_bit_cast(s16x4, __builtin_amdgcn_ds_read_tr16_b64_v4i16((LAS v4i16_t*)p)); }
#define MFMA32(a, b, c) __builtin_amdgcn_mfma_f32_32x32x16_bf16((a), (b), (c), 0, 0, 0)

#define XB_TMO      128
#define XB_XCNT(j)  (256  + 64 * (j))
#define XB_XSUB(j)  (1280 + 64 * (j))
#define XB_XGEN(j)  (2304 + 64 * (j))
#define XB_TOP      3328
#define XB_TOPGEN   3392
#define XCD_BAR_WORDS 3456
#define XB_SPIN_CAP (1u << 18)
__device__ __forceinline__ unsigned xb_ld(unsigned* p)              { return __hip_atomic_load(p, __ATOMIC_RELAXED, __HIP_MEMORY_SCOPE_AGENT); }
__device__ __forceinline__ unsigned xb_add(unsigned* p, unsigned v) { return __hip_atomic_fetch_add(p, v, __ATOMIC_RELAXED, __HIP_MEMORY_SCOPE_AGENT); }
__device__ __forceinline__ unsigned xb_xcc_id() { return (unsigned)__builtin_amdgcn_s_getreg((3 << 11) | 20) & 0xFu; }
#define XB_SPIN(cond, bar) do { unsigned _sp = 0; while (cond) { __builtin_amdgcn_s_sleep(1); \
    if ((++_sp & 255u) == 0u) { if (xb_ld(&(bar)[XB_TMO])) break; if (_sp > XB_SPIN_CAP) { atomicAdd(&(bar)[XB_TMO], 1u); break; } } } } while (0)
struct XcdBarrier { unsigned* bar; unsigned x; volatile LAS unsigned* st; };
__device__ __forceinline__ XcdBarrier xcd_barrier_post(unsigned* bar, volatile LAS unsigned* st) {
    XcdBarrier b; b.bar = bar; b.x = xb_xcc_id(); b.st = st;
    if (threadIdx.x == 0) (void)xb_add(&bar[XB_XCNT(b.x)], 1u);
    return b;
}
__device__ __forceinline__ void xcd_barrier_complete(unsigned* bar, unsigned x, unsigned& nloc, unsigned& nx) {
    const unsigned G = gridDim.x * gridDim.y * gridDim.z;
    unsigned sum, cnt, mine, sp = 0u;
    for (;;) {
        sum = 0u; cnt = 0u; mine = 0u;
#pragma unroll
        for (unsigned j = 0; j < 16; ++j) { const unsigned c = xb_ld(&bar[XB_XCNT(j)]); sum += c; cnt += (c > 0u) ? 1u : 0u; mine = (j == x) ? c : mine; }
        if (sum == G) break;
        __builtin_amdgcn_s_sleep(1);
        if ((++sp & 255u) == 0u) { if (xb_ld(&bar[XB_TMO])) break; if (sp > XB_SPIN_CAP) { atomicAdd(&bar[XB_TMO], 1u); break; } }
    }
    nloc = mine > 0u ? mine : 1u; nx = cnt > 0u ? cnt : 1u;
}
__device__ __forceinline__ void xcd_barrier(const XcdBarrier& b) {
    asm volatile("s_waitcnt vmcnt(0)" ::: "memory");
    __syncthreads();
    if (threadIdx.x == 0) {
        unsigned* bar = b.bar;
        __builtin_amdgcn_s_waitcnt(0);
        unsigned nloc = b.st[0], nx = b.st[1];
        if (nloc == 0u) { xcd_barrier_complete(bar, b.x, nloc, nx); b.st[0] = nloc; b.st[1] = nx; }
        const unsigned old = xb_add(&bar[XB_XSUB(b.x)], 1u);
        const unsigned gen = old / nloc;
        if (old + 1u == (gen + 1u) * nloc) {
            __builtin_amdgcn_fence(__ATOMIC_RELEASE, "agent");
            asm volatile("s_waitcnt vmcnt(0)" ::: "memory");
            const unsigned og = xb_add(&bar[XB_TOP], 1u);
            const unsigned tg = og / nx;
            if (og + 1u == (tg + 1u) * nx) xb_add(&bar[XB_TOPGEN], 1u);
            else XB_SPIN(xb_ld(&bar[XB_TOPGEN]) == tg, bar);
            __builtin_amdgcn_fence(__ATOMIC_ACQUIRE, "agent");
            xb_add(&bar[XB_XGEN(b.x)], 1u);
            asm volatile("s_waitcnt vmcnt(0)" ::: "memory");
        } else {
            XB_SPIN(xb_ld(&bar[XB_XGEN(b.x)]) == gen, bar);
            __builtin_amdgcn_fence(__ATOMIC_ACQUIRE, "agent");
            asm volatile("s_waitcnt vmcnt(0)" ::: "memory");
        }
    }
    __syncthreads();
}

namespace pg8 {
constexpr int BM = 256, BK = 64, HALF = 128, HTB = HALF * BK * 2, STAGE_BYTES = 8 * HTB, NXCD = 8, WGM = 8;
__device__ __forceinline__ int lds_byte(int r, int c) { const int st = (r >> 4) * 2 + (c >> 5), rr = r & 15, cc = c & 31, ob = rr * 64 + cc * 2; return st * 1024 + (ob ^ (((ob >> 9) & 1) << 5)); }
__device__ __forceinline__ void stage_rc(int b, int& R, int& C) { const int st = b / 1024, sb = b % 1024, swz = sb ^ (((sb >> 9) & 1) << 5); R = (st >> 1) * 16 + swz / 64; C = (st & 1) * 32 + (swz % 64) / 2; }
__device__ __forceinline__ int perm32(int rho) { const int n = rho >> 4, i = rho & 15; return 8 * (i >> 2) + 4 * n + (i & 3); }

struct Unit { int pm, pn, pc; unsigned kofs; int nt; };
struct Gemm { const bf16_t* A; const bf16_t* Bt; int K; int lda; LAS const unsigned* rowtab; int ldb; };

struct StaticOrder {
    int nM, nN, nwg, G, c;
    __device__ __forceinline__ void init(int nM_, int nN_, int G_, int c_) { nM = nM_; nN = nN_; nwg = nM * nN; G = G_; c = c_; }
    __device__ __forceinline__ bool map(int i, int& pm, int& pn) const {
        const long L = (long)i * G + c; if (L >= nwg) return false;
        int wgid = (int)L; { const int q = nwg / NXCD, r = nwg % NXCD, xcd = wgid % NXCD, off = wgid / NXCD; wgid = (xcd < r ? xcd * (q + 1) : r * (q + 1) + (xcd - r) * q) + off; }
        const int nig = WGM * nN, gid = wgid / nig, fm = gid * WGM, gsz = (nM - fm) < WGM ? (nM - fm) : WGM;
        pm = fm + ((wgid % nig) % gsz); pn = (wgid % nig) / gsz; return true;
    }
    __device__ __forceinline__ bool next(int i, Unit& u) const { int pm, pn; if (!map(i, pm, pn)) return false; u.pm = pm; u.pn = pn; u.pc = pn; u.kofs = 0u; return true; }
};
struct MoeOrder {
    StaticOrder so; const int* tile_e;
    __device__ __forceinline__ bool next(int i, Unit& u) const { int pm, pn; if (!so.map(i, pm, pn)) return false; u.pm = pm; u.pc = pn; u.pn = tile_e[pm] * so.nN + pn; u.kofs = 0u; return true; }
};

struct MoeDownOrder {
    int F, G, c; const int* tile_e;
    __device__ __forceinline__ bool next(int i, Unit& u) const { const int L = i * G + c; if (L >= F) return false; u.pm = L >> 2; u.pc = L & 3; u.pn = tile_e[u.pm] * 4 + u.pc; u.kofs = 0u; return true; }
};
struct MoeSplitOrder {
    int F, R, S, Ks, c; const int* tile_e;
    __device__ __forceinline__ bool next(int i, Unit& u) const { if (i > 0 || c >= R * S) return false; const int q = c / S, s = c % S; u.pm = (F >> 2) + (q >> 2); const int pc = q & 3;
        u.pn = tile_e[u.pm] * 4 + pc; u.pc = c; u.kofs = (unsigned)(s * Ks * 2); return true; }
};
struct MoeDownAll {
    StaticOrder so; const int* tile_e; int F, R, S, Ks, c, nw, ntw, nts;
    __device__ __forceinline__ bool next(int i, Unit& u) const { int pm, pn;
        if (so.map(i, pm, pn)) { u.pm = pm; u.pc = pn; u.pn = tile_e[pm] * 4 + pn; u.kofs = 0u; u.nt = ntw; return true; }
        if (R == 0 || i != nw || c >= R * S) return false;
        const int q = c / S, s = c % S; u.pm = (F >> 2) + (q >> 2); const int pc = q & 3;
        u.pn = tile_e[u.pm] * 4 + pc; u.pc = 0x10000 | c; u.kofs = (unsigned)(s * Ks * 2); u.nt = nts; return true; }
};
template <class Epi, class Sched, bool ALIGN_EPI, bool FP8 = false, bool VARK = false>
__device__ __forceinline__ void gemm_phase(LAS unsigned char* lds, const Gemm g, const Sched& S, const Epi& E) {
    const int tid = threadIdx.x, wid = __builtin_amdgcn_readfirstlane(tid >> 6), lane = tid & 63, wr = wid >> 2, wc = wid & 3, fr = lane & 15, fq = lane >> 4;
    const int K = g.K, nt = K / BK;
    int Ra[2]; unsigned Ca[2], voffB[2];
#pragma unroll
    for (int i = 0; i < 2; ++i) { int R, C; stage_rc(tid * 16 + i * 8192, R, C); const int Rb = Epi::PERM ? ((R & ~31) + perm32(R & 31)) : R;
        Ra[i] = R; Ca[i] = (unsigned)C * 2u; voffB[i] = (unsigned)(Rb * g.ldb + C) * 2u; }
    const unsigned kstep = (unsigned)(BK * 2);
    const size_t hstep = (size_t)HALF * g.ldb * 2;
    const size_t tstep = 2 * hstep;
    const unsigned rowb = (unsigned)g.lda * 2u;
    const unsigned ldsw = (unsigned)wid * 1024u;
    const int aoff = lds_byte(wr * 64 + fr, fq * 8), boff = lds_byte(wc * 32 + fr, fq * 8);
#define PG8_SA(b, h) (((b) * 2 + (h)) * HTB)
#define PG8_SB(b, h) ((4 + (b) * 2 + (h)) * HTB)
#define PG8_STAGE(bufoff, gbase, voff) do { _Pragma("unroll") for (int _i = 0; _i < 2; ++_i) \
        __builtin_amdgcn_global_load_lds((const unsigned*)((const char*)(gbase) + (voff)[_i]), (LAS unsigned*)(lds + (bufoff) + ldsw + _i * 8192), 16, 0, 0); } while (0)
#define PG8_STAGEA(bufoff, offs, kb) do { _Pragma("unroll") for (int _i = 0; _i < 2; ++_i) \
        __builtin_amdgcn_global_load_lds((const unsigned*)((const char*)g.A + (size_t)((offs)[_i] + (kb))), (LAS unsigned*)(lds + (bufoff) + ldsw + _i * 8192), 16, 0, 0); } while (0)
#define PG8_AOFF(dst, u, ui_) do { _Pragma("unroll") for (int _h = 0; _h < 2; ++_h) _Pragma("unroll") for (int _i = 0; _i < 2; ++_i) { \
        const int _rl = _h * 128 + Ra[_i]; \
        dst[_h][_i] = (g.rowtab ? g.rowtab[(ui_) * 256 + _rl] : (unsigned)((u).pm * 256 + _rl) * rowb) + Ca[_i] + (u).kofs; } } while (0)
#define PG8_LDA(dst, b, h) do { _Pragma("unroll") for (int m = 0; m < 4; ++m) _Pragma("unroll") for (int k = 0; k < 2; ++k) dst[m][k] = *(const LAS bf16x8*)(lds + PG8_SA(b, h) + aoff + m * 2048 + k * 1024); } while (0)
#define PG8_LDB(dst, b, h) do { _Pragma("unroll") for (int n = 0; n < 2; ++n) _Pragma("unroll") for (int k = 0; k < 2; ++k) dst[n][k] = *(const LAS bf16x8*)(lds + PG8_SB(b, h) + boff + n * 2048 + k * 1024); } while (0)
#define PG8_CAT8(x0, x1) __builtin_shufflevector(__builtin_bit_cast(u32x4, x0), __builtin_bit_cast(u32x4, x1), 0, 1, 2, 3, 4, 5, 6, 7)
#define PG8_MMA(ai, bj, At, Bt) do { __builtin_amdgcn_s_setprio(1); _Pragma("unroll") for (int m = 0; m < 4; ++m) _Pragma("unroll") for (int n = 0; n < 2; ++n) { \
        if constexpr (FP8) { acc[ai][bj][m][n] = __builtin_amdgcn_mfma_scale_f32_16x16x128_f8f6f4(__builtin_bit_cast(v8i32, PG8_CAT8(Bt[n][0], Bt[n][1])), __builtin_bit_cast(v8i32, PG8_CAT8(At[m][0], At[m][1])), acc[ai][bj][m][n], 0, 0, 0, 0, 0, 0); } \
        else { _Pragma("unroll") for (int k = 0; k < 2; ++k) acc[ai][bj][m][n] = __builtin_amdgcn_mfma_f32_16x16x32_bf16(Bt[n][k], At[m][k], acc[ai][bj][m][n], 0, 0, 0); } } __builtin_amdgcn_s_setprio(0); } while (0)
#define PG8_WAIT_V(n) asm volatile("s_waitcnt vmcnt(" #n ")" ::: "memory")
#define PG8_WAIT_L(n) asm volatile("s_waitcnt lgkmcnt(" #n ")" ::: "memory")
#define PG8_BAR __builtin_amdgcn_s_barrier()
#define PG8_SCHED __builtin_amdgcn_sched_barrier(0)
    Unit cur, nxt; int ui = 0;
    if (!S.next(0, cur)) return;
    f32x4 acc[2][2][4][2];
#pragma unroll
    for (int a = 0; a < 2; ++a)
#pragma unroll
        for (int b = 0; b < 2; ++b)
#pragma unroll
            for (int m = 0; m < 4; ++m)
#pragma unroll
                for (int n = 0; n < 2; ++n) acc[a][b][m][n] = (f32x4){0.f, 0.f, 0.f, 0.f};
    bf16x8 At[4][2], B0[2][2], B1[2][2];
    unsigned coff[2][2], noff[2][2];
    PG8_AOFF(coff, cur, 0);
    const char* cB = (const char*)g.Bt + (size_t)cur.pn * tstep + cur.kofs;
    PG8_STAGE(PG8_SB(0, 0), cB, voffB); PG8_STAGE(PG8_SB(0, 1), cB + hstep, voffB); PG8_STAGEA(PG8_SA(0, 0), coff[0], 0u); PG8_STAGEA(PG8_SA(0, 1), coff[1], 0u);
    if (wr == 1) PG8_BAR;
    PG8_WAIT_V(2); PG8_BAR;
    PG8_STAGE(PG8_SB(1, 0), cB + kstep, voffB); PG8_STAGEA(PG8_SA(1, 0), coff[0], kstep); PG8_STAGE(PG8_SB(1, 1), cB + hstep + kstep, voffB);
    PG8_WAIT_V(6); PG8_BAR;
    for (;;) {
        const bool has_next = S.next(ui + 1, nxt);
        if constexpr (FP8) { }
        else if (has_next) { PG8_AOFF(noff, nxt, ui + 1); }
        else {
#pragma unroll
            for (int h = 0; h < 2; ++h)
#pragma unroll
                for (int i = 0; i < 2; ++i) noff[h][i] = coff[h][i]; }
        const char* nB = has_next ? (const char*)g.Bt + (size_t)nxt.pn * tstep + nxt.kofs : cB;
        const int ntc = VARK ? cur.nt : nt;
        for (int t = 0; t < ntc; t += 2) {
            const bool last = (t == ntc - 2);
            const unsigned k1 = (unsigned)(t + 1) * kstep, k2 = (unsigned)(t + 2) * kstep;
            unsigned o2[2][2]; const unsigned kx = last ? 0u : k2;
            if constexpr (!FP8) {
#pragma unroll
                for (int h = 0; h < 2; ++h)
#pragma unroll
                    for (int i = 0; i < 2; ++i) o2[h][i] = last ? noff[h][i] : coff[h][i] + k2; }
#define PG8_STAGEA2(bufoff, h, kadd) do { if constexpr (FP8) { PG8_STAGEA(bufoff, coff[h], kx + (kadd)); } else { PG8_STAGEA(bufoff, o2[h], (kadd)); } } while (0)
            const char* b2 = last ? nB : cB + (size_t)k2;
            const char* b3 = b2 + kstep;
            PG8_LDB(B0, 0, 0); PG8_LDB(B1, 0, 1); PG8_SCHED; PG8_LDA(At, 0, 0); PG8_STAGEA(PG8_SA(1, 1), coff[1], k1);
            if constexpr (FP8) { if (last && has_next) { PG8_AOFF(coff, nxt, ui + 1); } }
            PG8_WAIT_V(8); PG8_WAIT_L(0); PG8_BAR; PG8_MMA(0, 0, At, B0); PG8_MMA(0, 1, At, B1); PG8_BAR; PG8_SCHED;
            PG8_LDA(At, 0, 1); PG8_STAGE(PG8_SB(0, 0), b2, voffB); PG8_STAGE(PG8_SB(0, 1), b2 + hstep, voffB); PG8_STAGEA2(PG8_SA(0, 0), 0, 0u);
            PG8_WAIT_V(8); PG8_WAIT_L(0); PG8_BAR; PG8_MMA(1, 0, At, B0); PG8_MMA(1, 1, At, B1); PG8_BAR; PG8_SCHED;
            PG8_LDB(B0, 1, 0); PG8_LDB(B1, 1, 1); PG8_SCHED; PG8_LDA(At, 1, 0); PG8_STAGEA2(PG8_SA(0, 1), 1, 0u);
            PG8_WAIT_V(8); PG8_WAIT_L(0); PG8_BAR; PG8_MMA(0, 0, At, B0); PG8_MMA(0, 1, At, B1); PG8_BAR; PG8_SCHED;
            PG8_LDA(At, 1, 1); PG8_STAGE(PG8_SB(1, 0), b3, voffB); PG8_STAGE(PG8_SB(1, 1), b3 + hstep, voffB); PG8_STAGEA2(PG8_SA(1, 0), 0, kstep);
            PG8_WAIT_V(8); PG8_WAIT_L(0); PG8_BAR; PG8_MMA(1, 0, At, B0); PG8_MMA(1, 1, At, B1); PG8_BAR; PG8_SCHED;
        }
        if constexpr (ALIGN_EPI) { if (wr == 0) PG8_BAR; }
        { int fr2 = fr, fq2 = fq; asm volatile("" : "+v"(fr2), "+v"(fq2));
          E(acc, cur, wr, wc, fr2, fq2); }
        if (!has_next) break;
#pragma unroll
        for (int a = 0; a < 2; ++a)
#pragma unroll
            for (int b = 0; b < 2; ++b)
#pragma unroll
                for (int m = 0; m < 4; ++m)
#pragma unroll
                    for (int n = 0; n < 2; ++n) acc[a][b][m][n] = (f32x4){0.f, 0.f, 0.f, 0.f};
        cur = nxt; cB = nB; ++ui;
        if constexpr (!FP8) {
#pragma unroll
            for (int h = 0; h < 2; ++h)
#pragma unroll
                for (int i = 0; i < 2; ++i) coff[h][i] = noff[h][i]; }
        if constexpr (ALIGN_EPI) { if (wr == 1) PG8_BAR; }
    }
    PG8_WAIT_V(0);
    if constexpr (!ALIGN_EPI) { if (wr == 0) PG8_BAR; }
    PG8_BAR;
#undef PG8_SA
#undef PG8_SB
#undef PG8_STAGE
#undef PG8_STAGEA
#undef PG8_STAGEA2
#undef PG8_AOFF
#undef PG8_LDA
#undef PG8_LDB
#undef PG8_MMA
#undef PG8_CAT8
#undef PG8_WAIT_V
#undef PG8_WAIT_L
#undef PG8_BAR
#undef PG8_SCHED
}

__device__ __forceinline__ void xpose4(unsigned (&r)[4], int fq) {
    { auto t = __builtin_amdgcn_permlane32_swap(r[0], r[2], false, false); r[0] = t[0]; r[2] = t[1]; }
    { auto t = __builtin_amdgcn_permlane32_swap(r[1], r[3], false, false); r[1] = t[0]; r[3] = t[1]; }
    const bool odd = fq & 1;
    { const unsigned rcv = (unsigned)__shfl_xor((int)(odd ? r[0] : r[1]), 16); if (odd) r[0] = rcv; else r[1] = rcv; }
    { const unsigned rcv = (unsigned)__shfl_xor((int)(odd ? r[2] : r[3]), 16); if (odd) r[2] = rcv; else r[3] = rcv; }
}
struct EpiStore {
    static constexpr bool PERM = true;
    bf16_t* O; int ldc;
    __device__ __forceinline__ void operator()(const f32x4 (&acc)[2][2][4][2], const Unit& u, int wr, int wc, int fr, int fq) const {
        const int row0 = u.pm * BM + wr * 64 + fr; const int col0 = u.pc * BM + wc * 32 + 8 * fq;
#pragma unroll
        for (int ai = 0; ai < 2; ++ai)
#pragma unroll
            for (int m = 0; m < 4; ++m) { bf16_t* rowp = O + (size_t)(row0 + ai * HALF + m * 16) * ldc + col0;
#pragma unroll
                for (int bj = 0; bj < 2; ++bj) { const f32x4 v0 = acc[ai][bj][m][0], v1 = acc[ai][bj][m][1];
                    u32x4 w; w.x = pk2(v0[0], v0[1]); w.y = pk2(v0[2], v0[3]); w.z = pk2(v1[0], v1[1]); w.w = pk2(v1[2], v1[3]);
                    *(u32x4*)(rowp + bj * HALF) = w; } }
    }
};
struct EpiPartial {
    static constexpr bool PERM = false;
    float* P;
    __device__ __forceinline__ void operator()(const f32x4 (&acc)[2][2][4][2], const Unit& u, int wr, int wc, int fr, int fq) const {
        float* base = P + (size_t)u.pc * 65536 + (size_t)(wr * 64 + fr) * 256 + wc * 32 + 4 * fq;
#pragma unroll
        for (int ai = 0; ai < 2; ++ai)
#pragma unroll
            for (int m = 0; m < 4; ++m) { float* rp = base + (size_t)(ai * HALF + m * 16) * 256; asm volatile("" : "+v"(rp));
#pragma unroll
                for (int bj = 0; bj < 2; ++bj)
#pragma unroll
                    for (int n = 0; n < 2; ++n) *(f32x4*)(rp + bj * HALF + n * 16) = acc[ai][bj][m][n]; }
    }
};
struct EpiSwiglu {
    static constexpr bool PERM = true;
    bf16_t* O; int ldc; float pre;
    __device__ __forceinline__ void operator()(const f32x4 (&acc)[2][2][4][2], const Unit& u, int wr, int wc, int fr, int fq) const {
        const int row0 = u.pm * BM + wr * 64 + fq * 16 + fr; const int col0 = u.pc * 128 + wc * 16;
#pragma unroll
        for (int ai = 0; ai < 2; ++ai)
#pragma unroll
            for (int bj = 0; bj < 2; ++bj) { unsigned lo[4], hi[4];
#pragma unroll
                for (int m = 0; m < 4; ++m) { const f32x4 v0 = acc[ai][bj][m][0] * pre, v1 = acc[ai][bj][m][1] * pre;
                    const float h0 = fsilu(v0[0]) * v0[1], h1 = fsilu(v0[2]) * v0[3], h2 = fsilu(v1[0]) * v1[1], h3 = fsilu(v1[2]) * v1[3];
                    lo[m] = pk2(h0, h1); hi[m] = pk2(h2, h3); }
                xpose4(lo, fq); xpose4(hi, fq);
                bf16_t* rowp = O + (size_t)(row0 + ai * HALF) * ldc + col0 + bj * 64;
                u32x4 w0; w0.x = lo[0]; w0.y = hi[0]; w0.z = lo[1]; w0.w = hi[1];
                u32x4 w1; w1.x = lo[2]; w1.y = hi[2]; w1.z = lo[3]; w1.w = hi[3];
                *(u32x4*)rowp = w0; *(u32x4*)(rowp + 8) = w1; }
    }
};
struct EpiSwigluQ8 {
    static constexpr bool PERM = true;
    unsigned char* O; int ldc; float pre;
    __device__ __forceinline__ void operator()(const f32x4 (&acc)[2][2][4][2], const Unit& u, int wr, int wc, int fr, int fq) const {
        const int row0 = u.pm * BM + wr * 64 + fq * 16 + fr; const int col0 = u.pc * 128 + wc * 16;
#pragma unroll
        for (int ai = 0; ai < 2; ++ai)
#pragma unroll
            for (int bj = 0; bj < 2; ++bj) { unsigned r[4];
#pragma unroll
                for (int m = 0; m < 4; ++m) { const f32x4 v0 = acc[ai][bj][m][0] * pre, v1 = acc[ai][bj][m][1] * pre;
                    const float h0 = fsilu(v0[0]) * v0[1], h1 = fsilu(v0[2]) * v0[3], h2 = fsilu(v1[0]) * v1[1], h3 = fsilu(v1[2]) * v1[3];
                    r[m] = pk4_fp8(h0, h1, h2, h3); }
                xpose4(r, fq);
                u32x4 w; w.x = r[0]; w.y = r[1]; w.z = r[2]; w.w = r[3];
                *(u32x4*)(O + (size_t)(row0 + ai * HALF) * ldc + col0 + bj * 64) = w; }
    }
};
struct EpiStoreS {
    static constexpr bool PERM = true;
    bf16_t* O; int ldc; float pre;
    __device__ __forceinline__ void operator()(const f32x4 (&acc)[2][2][4][2], const Unit& u, int wr, int wc, int fr, int fq) const {
        const int row0 = u.pm * BM + wr * 64 + fr; const int col0 = u.pc * BM + wc * 32 + 8 * fq;
#pragma unroll
        for (int ai = 0; ai < 2; ++ai)
#pragma unroll
            for (int m = 0; m < 4; ++m) { bf16_t* rowp = O + (size_t)(row0 + ai * HALF + m * 16) * ldc + col0;
#pragma unroll
                for (int bj = 0; bj < 2; ++bj) { const f32x4 v0 = acc[ai][bj][m][0] * pre, v1 = acc[ai][bj][m][1] * pre;
                    u32x4 w; w.x = pk2(v0[0], v0[1]); w.y = pk2(v0[2], v0[3]); w.z = pk2(v1[0], v1[1]); w.w = pk2(v1[2], v1[3]);
                    *(u32x4*)(rowp + bj * HALF) = w; } }
    }
};
struct EpiPartialS {
    static constexpr bool PERM = false;
    float* P; float pre;
    __device__ __forceinline__ void operator()(const f32x4 (&acc)[2][2][4][2], const Unit& u, int wr, int wc, int fr, int fq) const {
        float* base = P + (size_t)u.pc * 65536 + (size_t)(wr * 64 + fr) * 256 + wc * 32 + 4 * fq;
#pragma unroll
        for (int ai = 0; ai < 2; ++ai)
#pragma unroll
            for (int m = 0; m < 4; ++m)
#pragma unroll
                for (int bj = 0; bj < 2; ++bj)
#pragma unroll
                    for (int n = 0; n < 2; ++n) *(f32x4*)(base + (size_t)(ai * HALF + m * 16) * 256 + bj * HALF + n * 16) = acc[ai][bj][m][n] * pre;
    }
};
struct EpiDownAll {
    static constexpr bool PERM = true;
    bf16_t* O; int ldc; float pre; float* P;
    __device__ __forceinline__ void operator()(const f32x4 (&acc)[2][2][4][2], const Unit& u, int wr, int wc, int fr, int fq) const {
        if (u.pc < 0x10000) {
            const int row0 = u.pm * BM + wr * 64 + fr; const int col0 = u.pc * BM + wc * 32 + 8 * fq;
#pragma unroll
            for (int ai = 0; ai < 2; ++ai)
#pragma unroll
                for (int m = 0; m < 4; ++m) { bf16_t* rowp = O + (size_t)(row0 + ai * HALF + m * 16) * ldc + col0;
#pragma unroll
                    for (int bj = 0; bj < 2; ++bj) { const f32x4 v0 = acc[ai][bj][m][0] * pre, v1 = acc[ai][bj][m][1] * pre;
                        u32x4 w; w.x = pk2(v0[0], v0[1]); w.y = pk2(v0[2], v0[3]); w.z = pk2(v1[0], v1[1]); w.w = pk2(v1[2], v1[3]);
                        *(u32x4*)(rowp + bj * HALF) = w; } }
        } else {
            float* base = P + (size_t)(u.pc & 0xffff) * 65536 + (size_t)(wr * 64 + fr) * 256 + wc * 32 + 8 * fq;
#pragma unroll
            for (int ai = 0; ai < 2; ++ai)
#pragma unroll
                for (int m = 0; m < 4; ++m) { float* rp = base + (size_t)(ai * HALF + m * 16) * 256; asm volatile("" : "+v"(rp));
#pragma unroll
                    for (int bj = 0; bj < 2; ++bj)
#pragma unroll
                        for (int n = 0; n < 2; ++n) *(f32x4*)(rp + bj * HALF + n * 4) = acc[ai][bj][m][n]; }
        }
    }
};
struct EpiResidB {
    static constexpr bool PERM = true;
    const float* xin_f; const bf16_t* xin_b; bf16_t* xout; const float* gate; float pre;
    __device__ __forceinline__ void operator()(const f32x4 (&acc)[2][2][4][2], const Unit& u, int wr, int wc, int fr, int fq) const {
        const int row0 = u.pm * BM + wr * 64 + fr; const int col0 = u.pc * BM + wc * 32 + 8 * fq;
        f32x4 gv[2][2];
#pragma unroll
        for (int bj = 0; bj < 2; ++bj)
#pragma unroll
            for (int n = 0; n < 2; ++n) gv[bj][n] = *(const f32x4*)(gate + col0 + bj * HALF + n * 4) * pre;
#pragma unroll
        for (int ai = 0; ai < 2; ++ai)
#pragma unroll
            for (int mh = 0; mh < 2; ++mh) { f32x4 xa[2][2][2];
                if (xin_f) {
#pragma unroll
                    for (int mm = 0; mm < 2; ++mm)
#pragma unroll
                        for (int bj = 0; bj < 2; ++bj) { const float* p = xin_f + (size_t)(row0 + ai * HALF + (2 * mh + mm) * 16) * 1024 + col0 + bj * HALF; xa[mm][bj][0] = *(const f32x4*)p; xa[mm][bj][1] = *(const f32x4*)(p + 4); }
                } else { u32x4 wv[2][2];
#pragma unroll
                    for (int mm = 0; mm < 2; ++mm)
#pragma unroll
                        for (int bj = 0; bj < 2; ++bj) wv[mm][bj] = *(const u32x4*)(xin_b + (size_t)(row0 + ai * HALF + (2 * mh + mm) * 16) * 1024 + col0 + bj * HALF);
#pragma unroll
                    for (int mm = 0; mm < 2; ++mm)
#pragma unroll
                        for (int bj = 0; bj < 2; ++bj) { const u32x4 w = wv[mm][bj]; xa[mm][bj][0] = (f32x4){bflo(w.x), bfhi(w.x), bflo(w.y), bfhi(w.y)}; xa[mm][bj][1] = (f32x4){bflo(w.z), bfhi(w.z), bflo(w.w), bfhi(w.w)}; } }
                asm volatile("" ::: "memory");
#pragma unroll
                for (int mm = 0; mm < 2; ++mm)
#pragma unroll
                    for (int bj = 0; bj < 2; ++bj) { const int m = 2 * mh + mm; const f32x4 x0 = xa[mm][bj][0] + gv[bj][0] * acc[ai][bj][m][0], x1 = xa[mm][bj][1] + gv[bj][1] * acc[ai][bj][m][1];
                        u32x4 o; o.x = pk2(x0[0], x0[1]); o.y = pk2(x0[2], x0[3]); o.z = pk2(x1[0], x1[1]); o.w = pk2(x1[2], x1[3]);
                        *(u32x4*)(xout + (size_t)(row0 + ai * HALF + m * 16) * 1024 + col0 + bj * HALF) = o; } }
    }
};
struct EpiResid {
    static constexpr bool PERM = false;
    const float* xin_lat; const float* xin_ctx; float* xout_lat; float* xout_ctx; const float* gate_lat; const float* gate_ctx;
    __device__ __forceinline__ void operator()(const f32x4 (&acc)[2][2][4][2], const Unit& u, int wr, int wc, int fr, int fq) const {
        const bool isctx = u.pm >= 64; const int rbase = (isctx ? (u.pm - 64) : u.pm) * BM + wr * 64 + fr;
        const float* xin = isctx ? xin_ctx : xin_lat; float* xout = isctx ? xout_ctx : xout_lat; const float* gate = isctx ? gate_ctx : gate_lat;
        const int col0 = u.pc * BM + wc * 32 + 4 * fq;
        f32x4 gv[2][2];
#pragma unroll
        for (int bj = 0; bj < 2; ++bj)
#pragma unroll
            for (int n = 0; n < 2; ++n) gv[bj][n] = *(const f32x4*)(gate + col0 + bj * HALF + n * 16);
#pragma unroll
        for (int ai = 0; ai < 2; ++ai)
#pragma unroll
            for (int m = 0; m < 4; ++m) { const size_t off = (size_t)(rbase + ai * HALF + m * 16) * 1024 + col0;
#pragma unroll
                for (int bj = 0; bj < 2; ++bj)
#pragma unroll
                    for (int n = 0; n < 2; ++n) { const f32x4 xi = *(const f32x4*)(xin + off + bj * HALF + n * 16);
                        *(f32x4*)(xout + off + bj * HALF + n * 16) = xi + gv[bj][n] * acc[ai][bj][m][n]; } }
    }
};
}
namespace mk {
constexpr int SEQ = 16384, CTXL = 256, ROWS = SEQ + CTXL, DM = 1024;
constexpr float EPS = 1e-6f, LOG2E = 1.4426950408889634f;
constexpr int NTHR = 512, NCHUNK = 130, ZROW = SEQ;
constexpr size_t al256(size_t x) { return (x + 255) & ~(size_t)255; }
constexpr size_t WS_BAR = 0;
constexpr size_t WS_MOD = 16384;
constexpr size_t WS_CTXS = WS_MOD + al256(4 * 6144 * 4);
constexpr size_t WS_TOKE = WS_CTXS + (size_t)CTXL * DM * 4;
constexpr size_t WS_TOKW = WS_TOKE + (size_t)SEQ * 2 * 4;
constexpr size_t WS_TOKS = WS_TOKW + (size_t)SEQ * 2 * 4;
constexpr size_t WS_CNTG = WS_TOKS + (size_t)SEQ * 2 * 4;
constexpr size_t WS_ROWT = WS_CNTG + 256 * 8 * 4;
constexpr size_t WS_TILE = WS_ROWT + (size_t)136 * 256 * 4;
constexpr size_t WS_W1IN = WS_TILE + 1024;
constexpr size_t WS_W1UQ = WS_W1IN + (size_t)768 * 1024 * 2;
constexpr size_t WS_W1UKV = WS_W1UQ + (size_t)768 * 384 * 2;
constexpr size_t WS_W1OUT = WS_W1UKV + (size_t)1024 * 256 * 2;
constexpr size_t WS_WE13 = WS_W1OUT + (size_t)1024 * 512 * 2;
constexpr size_t WS_WE2 = WS_WE13 + (size_t)8 * 7168 * 1024 * 2;
constexpr size_t WS_REGA = WS_WE2 + (size_t)8 * 1024 * 3584 * 2;
constexpr size_t WS_W0IN = WS_REGA;
constexpr size_t WS_W0OUT = WS_W0IN + (size_t)2816 * 1024 * 2;
constexpr size_t WS_W013 = WS_W0OUT + (size_t)1024 * 1024 * 2;
constexpr size_t WS_W02 = WS_W013 + (size_t)5632 * 1024 * 2;
constexpr size_t WS_XN = WS_W02 + (size_t)1024 * 2816 * 2;
constexpr size_t WS_XB = WS_WE13 + ((size_t)80 << 20);
constexpr size_t WS_PART = WS_WE13;
constexpr size_t WS_Y = WS_REGA;
constexpr size_t WS_REGB = WS_REGA + (size_t)34816 * 1024 * 2;
constexpr size_t WS_HM = WS_REGB;
constexpr size_t WS_P0 = WS_REGB;
constexpr size_t WS_CAT = WS_P0 + (size_t)ROWS * 2816 * 2;
constexpr size_t WS_KP = WS_CAT + (size_t)ROWS * 1024 * 2;
constexpr size_t WS_RETU = WS_KP + (size_t)ROWS * 128 * 2;
constexpr size_t WS_RETS = WS_RETU + (size_t)16 * NCHUNK * 4096 * 4;
constexpr size_t WS_P1 = WS_REGB;
constexpr size_t WS_Q1 = WS_P1 + (size_t)ROWS * 768 * 2;
constexpr size_t WS_KV1 = WS_Q1 + (size_t)SEQ * 768 * 2;
constexpr size_t WS_K1 = WS_KV1 + (size_t)ROWS * 1024 * 2;
constexpr size_t WS_O1 = WS_K1 + (size_t)ROWS * 768 * 2;
constexpr size_t WS_KR = WS_O1 + (size_t)SEQ * 512 * 2;
constexpr size_t WS_ROPE = WS_REGB + (size_t)34816 * 3584 * 2;
constexpr size_t WS_END = WS_ROPE + 32768;
static_assert(WS_XN + (size_t)(ROWS + 1) * 2048 <= WS_REGB, "region A");
static_assert(WS_RETS + (size_t)16 * NCHUNK * 4096 * 2 <= WS_END && WS_KR + (size_t)ROWS * 64 <= WS_END, "region B");

struct Args { const float* in[34]; float* out; unsigned char* ws; int ph_lo, ph_hi; };
struct Ctx { const Args* a; LAS unsigned char* lds; int tid, lane, wid, b; };
#define WSP(T, off) ((T*)(A.ws + (off)))

__device__ __forceinline__ void ph_ada(const Args& A, const Ctx& c) {
    if (c.b >= 192) return;
    LAS float* sc = (LAS float*)c.lds; LAS float* scc = sc + 1024; LAS float* part = scc + 1024;
    const int L = c.b / 96, cb = (c.b % 96) * 64, cg = c.lane & 15, kq = c.lane >> 4;
    const float* w = L ? A.in[16] : A.in[4]; const float* bias = L ? A.in[17] : A.in[5];
    for (int i = c.tid; i < 1024; i += NTHR) { const float x = A.in[1][i], y = A.in[3][i]; sc[i] = x / (1.f + __expf(-x)); scc[i] = y / (1.f + __expf(-y)); }
    __syncthreads();
    f32x4 a0 = (f32x4){0.f, 0.f, 0.f, 0.f}, a1 = a0; const float* wp = w + (size_t)(c.wid * 128 + kq) * 6144 + cb + 4 * cg;
#pragma unroll
    for (int k = 0; k < 128; k += 4) { const f32x4 wv = *(const f32x4*)(wp + (size_t)k * 6144); const float s0 = sc[c.wid * 128 + k + kq], s1 = scc[c.wid * 128 + k + kq]; a0 = a0 + wv * s0; a1 = a1 + wv * s1; }
#pragma unroll
    for (int i = 0; i < 4; ++i) { a0[i] += __shfl_xor(a0[i], 16); a0[i] += __shfl_xor(a0[i], 32); a1[i] += __shfl_xor(a1[i], 16); a1[i] += __shfl_xor(a1[i], 32); }
    if (kq == 0) { *(LAS f32x4*)(part + (c.wid * 2 + 0) * 64 + 4 * cg) = a0; *(LAS f32x4*)(part + (c.wid * 2 + 1) * 64 + 4 * cg) = a1; }
    __syncthreads();
    if (c.tid < 128) { const int j = c.tid & 63, wh = c.tid >> 6; float s = bias[cb + j];
#pragma unroll
        for (int v = 0; v < 8; ++v) s += part[(v * 2 + wh) * 64 + j];
        WSP(float, WS_MOD)[(L * 2 + wh) * 6144 + cb + j] = s; }
    __syncthreads();
}

constexpr int WS_ADACNT = 4064;
__device__ __forceinline__ void ada_signal(const Args& A, const Ctx& c) {
    asm volatile("s_waitcnt vmcnt(0)" ::: "memory");
    __syncthreads();
    if (c.tid == 0) { __builtin_amdgcn_fence(__ATOMIC_RELEASE, "agent"); xb_add(WSP(unsigned, WS_BAR) + WS_ADACNT, 1u); }
}
__device__ __forceinline__ void ada_wait(const Args& A, const Ctx& c) {
    if (c.tid == 0) { unsigned* cnt = WSP(unsigned, WS_BAR) + WS_ADACNT; while (xb_ld(cnt) < gridDim.x) __builtin_amdgcn_s_sleep(1); __builtin_amdgcn_fence(__ATOMIC_ACQUIRE, "agent"); }
    __syncthreads();
}
struct CvtJob { const float* src; bf16_t* dst; int K, N, tn, rmul, roff, s0, s1, start; };
__device__ __forceinline__ void ph_convert(const Args& A, const Ctx& c) {
    LAS unsigned long long* jp = (LAS unsigned long long*)c.lds;
    LAS int* jm = (LAS int*)(c.lds + 1024);
    LAS int* total_p = (LAS int*)(c.lds + 4096 - 16);
    if (c.tid == 0) {
        int nj = 0, start = 0;
        auto add = [&](const float* src, bf16_t* dst, int K, int N, int Npad, int rmul, int roff, int s0, int s1) {
            jp[nj * 2] = (unsigned long long)(uintptr_t)src; jp[nj * 2 + 1] = (unsigned long long)(uintptr_t)dst;
            jm[nj * 8 + 0] = K; jm[nj * 8 + 1] = N; jm[nj * 8 + 2] = Npad / 256; jm[nj * 8 + 3] = rmul; jm[nj * 8 + 4] = roff; jm[nj * 8 + 5] = s0; jm[nj * 8 + 6] = s1; jm[nj * 8 + 7] = start;
            ++nj; start += (K / 64) * (Npad / 256); };
        for (int e = 0; e < 8; ++e) {
            add(A.in[31] + (size_t)e * 1024 * 3584, (bf16_t*)(WSP(unsigned char, WS_WE13) + (size_t)e * 7168 * 1024), 1024, 3584, 3584, 2, 0, -1, 0);
            add(A.in[32] + (size_t)e * 1024 * 3584, (bf16_t*)(WSP(unsigned char, WS_WE13) + (size_t)e * 7168 * 1024), 1024, 3584, 3584, 2, 1, -1, 0);
            add(A.in[33] + (size_t)e * 3584 * 1024, (bf16_t*)(WSP(unsigned char, WS_WE2) + (size_t)e * 1024 * 3584), 3584, 1024, 1024, 1, 0, -1, 0);
        }
        add(A.in[8], WSP(bf16_t, WS_W0IN), 1024, 2816, 2816, 1, 0, 512, 1024);
        add(A.in[12], WSP(bf16_t, WS_W0OUT), 1024, 1024, 1024, 1, 0, 0, 0);
        add(A.in[13], WSP(bf16_t, WS_W013), 1024, 2816, 2816, 2, 0, 0, 0);
        add(A.in[14], WSP(bf16_t, WS_W013), 1024, 2816, 2816, 2, 1, 0, 0);
        add(A.in[15], WSP(bf16_t, WS_W02), 2816, 1024, 1024, 1, 0, 0, 0);
        add(A.in[20], WSP(bf16_t, WS_W1IN), 1024, 672, 768, 1, 0, 0, 0);
        add(A.in[23], WSP(bf16_t, WS_W1UQ), 384, 768, 768, 1, 0, 0, 0);
        add(A.in[24], WSP(bf16_t, WS_W1UKV), 256, 1024, 1024, 1, 0, 0, 0);
        add(A.in[29], WSP(bf16_t, WS_W1OUT), 512, 1024, 1024, 1, 0, 0, 0);
        *total_p = start;
    }
    __syncthreads();
    const int total = *total_p;
    LAS unsigned char* img = c.lds + 4096;
    struct TM { bf16_t* dst; int K, rmul, roff, k0, n0; bool q8; float sc; };
#define CVT_LOAD(tq_, v_, m_) do { const bool val_ = (tq_) < total; const int t_ = val_ ? (tq_) : 0; int j_ = 0;        \
        j_ = t_ < 5376 ? t_ / 224 : 24 + (t_ >= 5552) + (t_ >= 5616) + (t_ >= 5792) + (t_ >= 5968) + (t_ >= 6144) + (t_ >= 6192) + (t_ >= 6210) + (t_ >= 6226);        \
        const float* src_ = (const float*)(uintptr_t)jp[j_ * 2]; const int N_ = jm[j_ * 8 + 1], tn_ = jm[j_ * 8 + 2], s0_ = jm[j_ * 8 + 5], s1_ = jm[j_ * 8 + 6]; \
        const int lt_ = t_ - jm[j_ * 8 + 7], lp_ = lt_ >> 1, tk_ = 2 * (lp_ / tn_) + (lt_ & 1), tq2_ = lp_ % tn_;        \
        m_.dst = (bf16_t*)(uintptr_t)jp[j_ * 2 + 1]; m_.K = jm[j_ * 8]; m_.rmul = jm[j_ * 8 + 3]; m_.roff = jm[j_ * 8 + 4]; m_.k0 = tk_ * 64; m_.n0 = tq2_ * 256; \
        const int nn_ = m_.n0 + 4 * c.lane; const bool ok_ = nn_ < N_; m_.q8 = s0_ < 0; m_.sc = !ok_ ? 0.f : (m_.q8 ? 64.f : ((nn_ >= s0_ && nn_ < s1_) ? 0.125f : 1.f)); \
        const float* sp_ = src_ + (val_ ? (size_t)m_.k0 * N_ + (ok_ ? nn_ : 0) : (size_t)0); const size_t rs_ = val_ ? (size_t)N_ : (size_t)0; \
        _Pragma("unroll") for (int q_ = 0; q_ < 8; ++q_) { const int kr_ = m_.q8 ? 2 * (c.wid + 8 * (q_ >> 1)) + (q_ & 1) : c.wid + 8 * q_; \
            v_[q_] = *(const GAS f32x4*)(uintptr_t)(sp_ + (size_t)kr_ * rs_); } } while (0)
    f32x4 va[8], vb[8], vd[8]; TM ma, mb, md; ma.dst = nullptr; ma.K = 0; ma.rmul = 0; ma.roff = 0; ma.k0 = 0; ma.n0 = 0; ma.q8 = false; ma.sc = 0.f; mb = ma; md = ma;
    const int G_ = (int)gridDim.x; int it = 0, buf = 0;
    const int rp_ = (total / 2) / G_;
#define CVT_TID(i_) ((i_) < 2 * rp_ ? 2 * (c.b + ((i_) >> 1) * G_) + ((i_) & 1) : ((i_) - 2 * rp_ < 2 ? 2 * rp_ * G_ + c.b + ((i_) - 2 * rp_) * G_ : total))
    const int g = c.lane >> 4, li = c.lane & 15, qrow = li >> 2, p = li & 3;
#define CVT_PROC(vc, mc) do { LAS unsigned char* im = img + buf * 32768; \
        if (!mc.q8) { \
            _Pragma("unroll") for (int q = 0; q < 8; ++q) { const int kk = c.wid + 8 * q; const f32x4 e = vc[q] * mc.sc; u32x2 w; w.x = pk2(e[0], e[1]); w.y = pk2(e[2], e[3]); \
                *(LAS u32x2*)(im + kk * 512 + ((c.lane * 8) ^ ((kk & 3) * 32))) = w; } \
            __syncthreads(); \
            _Pragma("unroll") for (int r = 0; r < 4; ++r) { const int nb = (c.wid & 3) + 4 * (g & 1) + 8 * (c.wid >> 2), kc = 2 * r + (g >> 1); \
                const int k = 8 * kc + qrow; const unsigned cb = (unsigned)((32 * nb + 8 * p) ^ (qrow * 32)); \
                const s16x4 a0 = ldtr(im + k * 512 + cb), a1 = ldtr(im + (k + 4) * 512 + cb); \
                u32x4 w; { const u32x2 lo = __builtin_bit_cast(u32x2, a0), hi2 = __builtin_bit_cast(u32x2, a1); w.x = lo.x; w.y = lo.y; w.z = hi2.x; w.w = hi2.y; } \
                *(GAS u32x4*)(uintptr_t)(mc.dst + ((size_t)(mc.n0 + 16 * nb + li) * mc.rmul + mc.roff) * mc.K + mc.k0 + 8 * kc) = w; } \
        } else {                                                     \
            _Pragma("unroll") for (int q2 = 0; q2 < 4; ++q2) { const int jj = c.wid + 8 * q2; const f32x4 e0 = vc[2 * q2] * mc.sc, e1 = vc[2 * q2 + 1] * mc.sc; u32x2 w; \
                { int pa = __builtin_amdgcn_cvt_pk_fp8_f32(e0[0], e1[0], 0, false); pa = __builtin_amdgcn_cvt_pk_fp8_f32(e0[1], e1[1], pa, true); w.x = (unsigned)pa; \
                  int pb = __builtin_amdgcn_cvt_pk_fp8_f32(e0[2], e1[2], 0, false); pb = __builtin_amdgcn_cvt_pk_fp8_f32(e0[3], e1[3], pb, true); w.y = (unsigned)pb; } \
                *(LAS u32x2*)(im + jj * 512 + ((c.lane * 8) ^ ((jj & 3) * 32))) = w; } \
            __syncthreads(); \
            unsigned char* dstb = (unsigned char*)mc.dst; \
            _Pragma("unroll") for (int r = 0; r < 2; ++r) { const int nb = (c.wid & 3) + 4 * (g & 1) + 8 * (c.wid >> 2), kc = 2 * r + (g >> 1);        \
                const int jr = 8 * kc + qrow; const unsigned cb = (unsigned)((32 * nb + 8 * p) ^ (qrow * 32)); \
                const s16x4 a0 = ldtr(im + jr * 512 + cb), a1 = ldtr(im + (jr + 4) * 512 + cb); \
                u32x4 w; { const u32x2 lo = __builtin_bit_cast(u32x2, a0), hi2 = __builtin_bit_cast(u32x2, a1); w.x = lo.x; w.y = lo.y; w.z = hi2.x; w.w = hi2.y; } \
                *(GAS u32x4*)(uintptr_t)(dstb + ((size_t)(mc.n0 + 16 * nb + li) * mc.rmul + mc.roff) * mc.K + mc.k0 + 16 * kc) = w; } \
        } \
        buf ^= 1; } while (0)
    CVT_LOAD(CVT_TID(0), va, ma);
    CVT_LOAD(CVT_TID(1), vb, mb);
    for (;;) {
        if (CVT_TID(it) >= total) break;
        CVT_LOAD(CVT_TID(it + 2), vd, md);
        CVT_PROC(va, ma); ++it;
        if (CVT_TID(it) >= total) break;
        CVT_LOAD(CVT_TID(it + 2), va, ma);
        CVT_PROC(vb, mb); ++it;
        if (CVT_TID(it) >= total) break;
        CVT_LOAD(CVT_TID(it + 2), vb, mb);
        CVT_PROC(vd, md); ++it;
    }
#undef CVT_TID
#undef CVT_PROC
#undef CVT_LOAD
    __syncthreads();
}

template <bool ROUTE, bool XB16, int NROW>
__device__ __forceinline__ void mod_batch(const Args& A, const Ctx& c, const float* xl, const float* xc, int bt, const f32x4 (&pa)[4], const f32x4 (&pb)[4], bf16_t* XN, LAS float* rt, LAS int* cnt) {
    constexpr bool isctx = NROW == 1;
    f32x4 v[NROW][4];
#pragma unroll
    for (int u = 0; u < NROW; ++u) { const float* xr = isctx ? xc + (size_t)c.b * DM : xl + (size_t)(c.b * 64 + c.wid * 8 + bt * 4 + u) * DM;
#pragma unroll
        for (int i = 0; i < 4; ++i) {
            if (XB16 && !isctx) { const u32x2 w = *(const u32x2*)((const bf16_t*)xl + (size_t)(c.b * 64 + c.wid * 8 + bt * 4 + u) * DM + 4 * c.lane + 256 * i); v[u][i] = (f32x4){bflo(w.x), bfhi(w.x), bflo(w.y), bfhi(w.y)}; }
            else v[u][i] = *(const f32x4*)(xr + 4 * c.lane + 256 * i); } }
#pragma unroll
    for (int u = 0; u < NROW; ++u) {
        const int row = isctx ? SEQ + c.b : c.b * 64 + c.wid * 8 + bt * 4 + u;
        float ss = 0.f;
#pragma unroll
        for (int i = 0; i < 4; ++i) ss += v[u][i][0] * v[u][i][0] + v[u][i][1] * v[u][i][1] + v[u][i][2] * v[u][i][2] + v[u][i][3] * v[u][i][3];
        ss = wsum(ss); const float rs = rsqrtf(ss * (1.f / DM) + EPS);
        float lg[8];
#pragma unroll
        for (int e = 0; e < 8; ++e) lg[e] = 0.f;
#pragma unroll
        for (int i = 0; i < 4; ++i) { const int col = 4 * c.lane + 256 * i;
            const f32x4 y = v[u][i] * rs * pa[i] + pb[i];
            if (ROUTE) *(unsigned*)((unsigned char*)XN + (size_t)row * DM + col) = pk4_fp8(y[0], y[1], y[2], y[3]);
            else { u32x2 w; w.x = pk2(y[0], y[1]); w.y = pk2(y[2], y[3]); *(u32x2*)(XN + (size_t)row * DM + col) = w; }
            if (ROUTE) {
#pragma unroll
                for (int e = 0; e < 8; ++e) { const f32x4 r = *(const LAS f32x4*)(rt + e * 1024 + col); lg[e] += y[0] * r[0] + y[1] * r[1] + y[2] * r[2] + y[3] * r[3]; } } }
        if (ROUTE) {
#pragma unroll
            for (int e = 0; e < 8; ++e) lg[e] = wsum(lg[e]);
            if (c.lane == 0) { int i0 = 0; float v0 = lg[0];
#pragma unroll
                for (int e = 1; e < 8; ++e) if (lg[e] > v0) { v0 = lg[e]; i0 = e; }
                int i1 = 0; float v1 = -INFINITY;
#pragma unroll
                for (int e = 0; e < 8; ++e) if (e != i0 && lg[e] > v1) { v1 = lg[e]; i1 = e; }
                const float e1 = __expf(v1 - v0), w0 = 1.f / (1.f + e1);
                WSP(int, WS_TOKE)[row * 2] = i0; WSP(int, WS_TOKE)[row * 2 + 1] = i1; WSP(float, WS_TOKW)[row * 2] = w0; WSP(float, WS_TOKW)[row * 2 + 1] = e1 * w0;
                atomicAdd((int*)(cnt + i0), 1); atomicAdd((int*)(cnt + i1), 1); } }
    }
}
template <bool HAS_CTX, bool ROUTE, bool XB16 = false>
__device__ __forceinline__ void ph_modulate(const Args& A, const Ctx& c, const float* xl, const float* xc, const float* g, const float* mod_l, const float* mod_c, int ish, int isc) {
    bf16_t* XN = WSP(bf16_t, WS_XN);
    LAS float* rt = (LAS float*)c.lds;
    LAS int* cnt = (LAS int*)(c.lds + 32768);
    if (ROUTE) { for (int i = c.tid; i < 2048; i += NTHR) { const f32x4 r = *(const f32x4*)(A.in[30] + i * 4); const int d = i >> 1, e0 = (i & 1) * 4;
                     rt[(e0 + 0) * 1024 + d] = r[0]; rt[(e0 + 1) * 1024 + d] = r[1]; rt[(e0 + 2) * 1024 + d] = r[2]; rt[(e0 + 3) * 1024 + d] = r[3]; }
                 if (c.tid < 8) cnt[c.tid] = 0;
                 if (c.b == 0) { for (int i = c.tid; i < 256; i += NTHR) *(unsigned*)((unsigned char*)XN + (size_t)ZROW * DM + i * 4) = 0u; }
                 __syncthreads(); }
    const bool has_c = HAS_CTX && c.wid == (c.b & 7);
    f32x4 pa[4], pb[4];
#pragma unroll
    for (int i = 0; i < 4; ++i) { const int col = 4 * c.lane + 256 * i; pa[i] = *(const f32x4*)(g + col) * (*(const f32x4*)(mod_l + isc * DM + col) + 1.f); pb[i] = *(const f32x4*)(mod_l + ish * DM + col); }
    f32x4 pca[4], pcb[4];
#pragma unroll
    for (int i = 0; i < 4; ++i) { const int col = 4 * c.lane + 256 * i; pca[i] = pa[i]; pcb[i] = pb[i];
        if (HAS_CTX) { pca[i] = *(const f32x4*)(g + col) * (*(const f32x4*)(mod_c + isc * DM + col) + 1.f); pcb[i] = *(const f32x4*)(mod_c + ish * DM + col); } }
    for (int bt = 0; bt < 2; ++bt) mod_batch<ROUTE, XB16, 4>(A, c, xl, xc, bt, pa, pb, XN, rt, cnt);
    if (has_c) mod_batch<ROUTE, XB16, 1>(A, c, xl, xc, 2, pca, pcb, XN, rt, cnt);
    if (ROUTE) { __syncthreads(); if (c.tid < 8) WSP(int, WS_CNTG)[c.b * 8 + c.tid] = cnt[c.tid]; __syncthreads(); }
}

__device__ __forceinline__ void ph_plan(const Args& A, const Ctx& c) {
    LAS int* call = (LAS int*)c.lds;
    LAS int* tot = call + 2048; LAS int* myb = tot + 8; LAS int* eb = myb + 8; LAS int* te = eb + 16;
    for (int i = c.tid; i < 2048; i += NTHR) call[i] = WSP(int, WS_CNTG)[i];
    if (c.tid < 128) te[c.tid] = WSP(int, WS_TOKE)[c.b * 128 + c.tid];
    __syncthreads();
    { LAS int* ps = te + 128;
      if (c.tid < 256) { const int e = c.tid & 7, part = c.tid >> 3; int t = 0, mb = 0;
#pragma unroll
          for (int k = 0; k < 8; ++k) { const int bb = part * 8 + k; const int q = call[bb * 8 + e]; if (bb < c.b) mb += q; t += q; }
          ps[(part * 8 + e) * 2] = t; ps[(part * 8 + e) * 2 + 1] = mb; }
      __syncthreads();
      if (c.tid < 8) { int t = 0, mb = 0; for (int part = 0; part < 32; ++part) { t += ps[(part * 8 + c.tid) * 2]; mb += ps[(part * 8 + c.tid) * 2 + 1]; } tot[c.tid] = t; myb[c.tid] = mb; } }
    __syncthreads();
    if (c.tid == 0) { int s = 0; for (int e = 0; e < 8; ++e) { eb[e] = s; s += (tot[e] + 255) / 256 * 256; } eb[8] = s; }
    __syncthreads();
    unsigned* rowt = WSP(unsigned, WS_ROWT);
    { LAS int* w0cnt = te + 128 + 512;
      int rank = 0, e = 0;
      if (c.tid < 128) { e = te[c.tid];
#pragma unroll
          for (int k = 0; k < 8; ++k) { const unsigned long long m = __ballot(e == k); if (e == k) rank = __popcll(m & ((1ull << c.lane) - 1ull)); if (c.tid < 64 && c.lane == 0) w0cnt[k] = __popcll(m); } }
      __syncthreads();
      if (c.tid < 128) { const int pos = eb[e] + myb[e] + rank + (c.tid >= 64 ? w0cnt[e] : 0);
          rowt[pos] = (unsigned)(c.b * 64 + (c.tid >> 1)) * 1024u; WSP(int, WS_TOKS)[c.b * 128 + c.tid] = pos; } }
    if (c.b < 8) { for (int s = eb[c.b] + tot[c.b] + c.tid; s < eb[c.b + 1]; s += NTHR) rowt[s] = (unsigned)ZROW * 1024u; }
    if (c.b == 8 && c.tid < 256) { int e = 0;
        if (c.tid < 136) { e = -1;
#pragma unroll
            for (int k = 0; k < 8; ++k) if (c.tid * 256 >= eb[k] && c.tid * 256 < eb[k + 1]) e = k; }
        if (c.tid == 255) e = eb[8] / 256;
        WSP(int, WS_TILE)[c.tid] = e; }
    __syncthreads();
}

constexpr int WS_SPLITCNT = 3456;
__device__ __forceinline__ void moe_split_fixup(const Args& A, const Ctx& c, int F, int S) {
    const int q = c.b / S, s = c.b % S; unsigned* cnt = WSP(unsigned, WS_BAR) + WS_SPLITCNT + 16 * q;
    asm volatile("s_waitcnt vmcnt(0)" ::: "memory");
    __syncthreads();
    if (c.tid == 0) { __builtin_amdgcn_fence(__ATOMIC_RELEASE, "agent"); xb_add(cnt, 1u);
        while (xb_ld(cnt) < (unsigned)S) __builtin_amdgcn_s_sleep(1);
        __builtin_amdgcn_fence(__ATOMIC_ACQUIRE, "agent"); }
    __syncthreads();
    const int pm = (F >> 2) + (q >> 2), pc = q & 3; const float* P = WSP(float, WS_PART) + (size_t)(q * S) * 65536; bf16_t* Y = WSP(bf16_t, WS_Y);
    const int lo = (int)(((long)s * 16384) / S), hi = (int)(((long)(s + 1) * 16384) / S);
    for (int e = lo + c.tid; e < hi; e += NTHR) { f32x4 a = *(const f32x4*)(P + (size_t)e * 4);
        for (int k = 1; k < S; ++k) a = a + *(const f32x4*)(P + (size_t)k * 65536 + (size_t)e * 4);
        a = a * (1.f / 64.f);
        const int row = e >> 6, col = (e & 63) * 4; u32x2 w; w.x = pk2(a[0], a[1]); w.y = pk2(a[2], a[3]);
        *(u32x2*)(Y + (size_t)(pm * 256 + row) * DM + pc * 256 + col) = w; }
}

__device__ __forceinline__ void ph_combine(const Args& A, const Ctx& c) {
    const float* g5 = WSP(float, WS_MOD) + 2 * 6144 + 5 * DM; const bf16_t* Y = WSP(bf16_t, WS_Y); const bf16_t* XB = WSP(bf16_t, WS_XB);
    const int tb = c.b * 64 + c.wid * 8;
    f32x4 ghv[4];
#pragma unroll
    for (int i = 0; i < 4; ++i) ghv[i] = *(const f32x4*)(g5 + 4 * c.lane + 256 * i);
    for (int q0 = 0; q0 < 8; q0 += 4) {
        int sl[4][2]; float wt[4][2];
#pragma unroll
        for (int u = 0; u < 4; ++u) { const int t = tb + q0 + u; sl[u][0] = WSP(int, WS_TOKS)[t * 2]; sl[u][1] = WSP(int, WS_TOKS)[t * 2 + 1]; wt[u][0] = WSP(float, WS_TOKW)[t * 2]; wt[u][1] = WSP(float, WS_TOKW)[t * 2 + 1]; }
        u32x2 ya[4][4], yb[4][4], xx[4][4];
#pragma unroll
        for (int u = 0; u < 4; ++u)
#pragma unroll
            for (int i = 0; i < 4; ++i) { const int col = 4 * c.lane + 256 * i;
                ya[u][i] = *(const u32x2*)(Y + (size_t)sl[u][0] * DM + col); yb[u][i] = *(const u32x2*)(Y + (size_t)sl[u][1] * DM + col); xx[u][i] = *(const u32x2*)(XB + (size_t)(tb + q0 + u) * DM + col); }
#pragma unroll
        for (int u = 0; u < 4; ++u)
#pragma unroll
            for (int i = 0; i < 4; ++i) { const int col = 4 * c.lane + 256 * i; const f32x4 gg = ghv[i]; f32x4 x = (f32x4){bflo(xx[u][i].x), bfhi(xx[u][i].x), bflo(xx[u][i].y), bfhi(xx[u][i].y)}; const float w0 = wt[u][0], w1 = wt[u][1];
                x[0] += gg[0] * (w0 * bflo(ya[u][i].x) + w1 * bflo(yb[u][i].x)); x[1] += gg[1] * (w0 * bfhi(ya[u][i].x) + w1 * bfhi(yb[u][i].x));
                x[2] += gg[2] * (w0 * bflo(ya[u][i].y) + w1 * bflo(yb[u][i].y)); x[3] += gg[3] * (w0 * bfhi(ya[u][i].y) + w1 * bfhi(yb[u][i].y));
                *(f32x4*)(A.out + (size_t)(tb + q0 + u) * DM + col) = x; }
    }
}

__device__ __forceinline__ void ctx_gemm_resid(const Ctx& c, const bf16_t* Actx, int lda, const bf16_t* Bt, int K, const float* xin, float* xout, const float* gate) {
    const int tr = c.b >> 5, tc = c.b & 31, r32 = c.lane & 31, hi = c.lane >> 5, K8 = K >> 3;
    const bf16_t* ap = Actx + (size_t)(32 * tr + r32) * lda + 8 * hi + c.wid * K8; const bf16_t* bp = Bt + (size_t)(32 * tc + r32) * K + 8 * hi + c.wid * K8;
    f32x16 acc = (f32x16){};
#pragma unroll 8
    for (int k0 = 0; k0 < K8; k0 += 16) { const bf16x8 av = *(const bf16x8*)(ap + k0), bv = *(const bf16x8*)(bp + k0); acc = MFMA32(bv, av, acc); }
    LAS float* ex = (LAS float*)c.lds;
#pragma unroll
    for (int r = 0; r < 16; ++r) ex[(c.wid * 16 + r) * 64 + c.lane] = acc[r];
    __syncthreads();
#pragma unroll
    for (int q = 0; q < 2; ++q) { const int r = 2 * c.wid + q; float s = 0.f;
#pragma unroll
        for (int w = 0; w < 8; ++w) s += ex[(w * 16 + r) * 64 + c.lane];
        const int col = 32 * tc + crow(r, hi); const size_t off = (size_t)(32 * tr + r32) * DM + col;
        xout[off] = xin[off] + gate[col] * s; }
    __syncthreads();
}

__device__ __forceinline__ void ph_rope_table(const Args& A, const Ctx& c) {
    float2* T = WSP(float2, WS_ROPE);
    for (int e = c.b * NTHR + c.tid; e < 4096; e += (int)gridDim.x * NTHR) { const int pos = e >> 4, f = e & 15;
        const float invf = powf(10000.f, -(float)(2 * f) * (1.f / 32.f)); const float ang = (float)pos * invf; T[e] = make_float2(cosf(ang), sinf(ang)); }
}
__device__ __forceinline__ void rope_pair(float& x0, float& x1, const float2* T, int pos, int f) {
    const float2 cs = T[pos * 16 + f];
    const float a = x0 * cs.x - x1 * cs.y, b2 = x0 * cs.y + x1 * cs.x; x0 = a; x1 = b2;
}

__device__ __forceinline__ void ph_kprep0(const Args& A, const Ctx& c) {
    const bf16_t* P0 = WSP(bf16_t, WS_P0); bf16_t* KP = WSP(bf16_t, WS_KP); const float* kg = A.in[11];
    if (c.b < 8) return;
    const int stride = ((int)gridDim.x - 8) * 8, kvh = c.lane >> 5, pr = c.lane & 31; const float g0 = kg[2 * pr], g1 = kg[2 * pr + 1];
    for (int base = (c.b - 8) * 8 + c.wid; base < ROWS; base += stride * 4) {
        unsigned w[4]; float2 cs[4];
#pragma unroll
        for (int u = 0; u < 4; ++u) { const int row = base + u * stride < ROWS ? base + u * stride : 0; w[u] = *(const unsigned*)(P0 + (size_t)row * 2816 + 2560 + 2 * c.lane);
            const int rr = row < SEQ ? row : 0; cs[u] = WSP(float2, WS_ROPE)[(pr < 16 ? rr / 64 : rr % 64) * 16 + (pr & 15)]; if (row >= SEQ) cs[u] = make_float2(1.f, 0.f); }
#pragma unroll
        for (int u = 0; u < 4; ++u) { const int row = base + u * stride; if (row < ROWS) {
            float x0 = bflo(w[u]), x1 = bfhi(w[u]); float ss = x0 * x0 + x1 * x1;
            ss += __shfl_xor(ss, 1); ss += __shfl_xor(ss, 2); ss += __shfl_xor(ss, 4); ss += __shfl_xor(ss, 8); ss += __shfl_xor(ss, 16);
            const float rs = rsqrtf(ss * (1.f / 64.f) + EPS); x0 *= rs * g0; x1 *= rs * g1;
            { const float a = x0 * cs[u].x - x1 * cs[u].y, b2 = x0 * cs[u].y + x1 * cs[u].x; x0 = a; x1 = b2; }
            *(unsigned*)(KP + (size_t)row * 128 + kvh * 64 + 2 * pr) = pk2(x0, x1); } }
    }
}
__device__ __forceinline__ void ph_prep1a(const Args& A, const Ctx& c) {
    bf16_t* P1 = WSP(bf16_t, WS_P1); bf16_t* KR = WSP(bf16_t, WS_KR); const float* gq = A.in[21]; const float* gkv = A.in[22]; const float* gkr = A.in[28];
    const int stride = gridDim.x * 8;
    float hq[3][2], hkv[2][2], hkr[2];
#pragma unroll
    for (int i = 0; i < 3; ++i) { hq[i][0] = gq[2 * c.lane + 128 * i]; hq[i][1] = gq[2 * c.lane + 128 * i + 1]; }
#pragma unroll
    for (int i = 0; i < 2; ++i) { hkv[i][0] = gkv[2 * c.lane + 128 * i]; hkv[i][1] = gkv[2 * c.lane + 128 * i + 1]; }
    hkr[0] = gkr[(2 * c.lane) & 31]; hkr[1] = gkr[(2 * c.lane + 1) & 31];
    for (int base = c.b * 8 + c.wid; base < ROWS; base += stride * 4) {
        unsigned wq[4][3], wk[4][2], wr[4]; float2 csr[4];
#pragma unroll
        for (int u = 0; u < 4; ++u) { const int row = base + u * stride; const bf16_t* pr = P1 + (size_t)(row < ROWS ? row : 0) * 768;
#pragma unroll
            for (int i = 0; i < 3; ++i) wq[u][i] = *(const unsigned*)(pr + 2 * c.lane + 128 * i);
#pragma unroll
            for (int i = 0; i < 2; ++i) wk[u][i] = *(const unsigned*)(pr + 384 + 2 * c.lane + 128 * i);
            wr[u] = c.lane < 16 ? *(const unsigned*)(pr + 640 + 2 * c.lane) : 0u;
            { const int rr = row < SEQ ? row : 0; csr[u] = WSP(float2, WS_ROPE)[(c.lane < 8 ? rr / 64 : rr % 64) * 16 + 2 * (c.lane & 7)]; if (row >= SEQ) csr[u] = make_float2(1.f, 0.f); } }
#pragma unroll
        for (int u = 0; u < 4; ++u) { const int row = base + u * stride; if (row < ROWS) { bf16_t* pr = P1 + (size_t)row * 768;
            if (row < SEQ) { float ss = 0.f;
#pragma unroll
                for (int i = 0; i < 3; ++i) { const float a0 = bflo(wq[u][i]), a1 = bfhi(wq[u][i]); ss += a0 * a0 + a1 * a1; }
                ss = wsum(ss); const float rs = rsqrtf(ss * (1.f / 384.f) + EPS);
#pragma unroll
                for (int i = 0; i < 3; ++i) { const int col = 2 * c.lane + 128 * i; *(unsigned*)(pr + col) = pk2(bflo(wq[u][i]) * rs * hq[i][0], bfhi(wq[u][i]) * rs * hq[i][1]); } }
            { float ss = 0.f;
#pragma unroll
                for (int i = 0; i < 2; ++i) { const float a0 = bflo(wk[u][i]), a1 = bfhi(wk[u][i]); ss += a0 * a0 + a1 * a1; }
                ss = wsum(ss); const float rs = rsqrtf(ss * (1.f / 256.f) + EPS);
#pragma unroll
                for (int i = 0; i < 2; ++i) { const int col = 2 * c.lane + 128 * i; *(unsigned*)(pr + 384 + col) = pk2(bflo(wk[u][i]) * rs * hkv[i][0], bfhi(wk[u][i]) * rs * hkv[i][1]); } }
            { float x0 = bflo(wr[u]), x1 = bfhi(wr[u]);
                const float ss = wsum(x0 * x0 + x1 * x1); const float rs = rsqrtf(ss * (1.f / 32.f) + EPS);
                if (c.lane < 16) { x0 *= rs * hkr[0]; x1 *= rs * hkr[1];
                    { const float a = x0 * csr[u].x - x1 * csr[u].y, b2 = x0 * csr[u].y + x1 * csr[u].x; x0 = a; x1 = b2; }
                    *(unsigned*)(KR + (size_t)row * 32 + 2 * c.lane) = pk2(x0, x1); } } } }
    }
}
__device__ __forceinline__ void ph_prep1b(const Args& A, const Ctx& c) {
    const bf16_t* KV = WSP(bf16_t, WS_KV1); const bf16_t* KR = WSP(bf16_t, WS_KR); bf16_t* K1 = WSP(bf16_t, WS_K1); const float* gk = A.in[27];
    const int stride = gridDim.x * 8, h = c.lane >> 3, part = c.lane & 7, hr = c.lane >> 2, pr = c.lane & 3;
    const f32x4 ga = *(const f32x4*)(gk + part * 8), gb = *(const f32x4*)(gk + part * 8 + 4);
    for (int base = c.b * 8 + c.wid; base < ROWS; base += stride * 4) {
        u32x4 w[4], kr[4];
#pragma unroll
        for (int u = 0; u < 4; ++u) { const int row = base + u * stride < ROWS ? base + u * stride : 0;
            w[u] = *(const u32x4*)(KV + (size_t)row * 1024 + h * 128 + part * 8); kr[u] = (u32x4){0u, 0u, 0u, 0u};
            if (c.lane < 32) kr[u] = *(const u32x4*)(KR + (size_t)row * 32 + pr * 8); }
#pragma unroll
        for (int u = 0; u < 4; ++u) { const int row = base + u * stride; if (row < ROWS) {
            float x[8]; float ss = 0.f;
#pragma unroll
            for (int k = 0; k < 4; ++k) { x[2 * k] = bflo(w[u][k]); x[2 * k + 1] = bfhi(w[u][k]); ss += x[2 * k] * x[2 * k] + x[2 * k + 1] * x[2 * k + 1]; }
            ss += __shfl_xor(ss, 1); ss += __shfl_xor(ss, 2); ss += __shfl_xor(ss, 4);
            const float rs = rsqrtf(ss * (1.f / 64.f) + EPS);
            u32x4 o; o.x = pk2(x[0] * rs * ga[0], x[1] * rs * ga[1]); o.y = pk2(x[2] * rs * ga[2], x[3] * rs * ga[3]); o.z = pk2(x[4] * rs * gb[0], x[5] * rs * gb[1]); o.w = pk2(x[6] * rs * gb[2], x[7] * rs * gb[3]);
            *(u32x4*)(K1 + (size_t)row * 768 + h * 96 + part * 8) = o;
            if (c.lane < 32) *(u32x4*)(K1 + (size_t)row * 768 + hr * 96 + 64 + pr * 8) = kr[u]; } }
    }
}

__device__ __forceinline__ int ret_rowbase(int ck) { return ck < 2 ? SEQ + 128 * ck : 128 * (ck - 2); }
__device__ __forceinline__ unsigned swzV(int m, int cbyte) { return (unsigned)(m * 128 + (cbyte ^ (((m >> 1) & 1) * 64))); }

__device__ __forceinline__ void ph_ret1(const Args& A, const Ctx& c) {
    const bf16_t* P0 = WSP(bf16_t, WS_P0); float* U = WSP(float, WS_RETU); const float* ld = A.in[9];
    const int r32 = c.lane & 31, hi = c.lane >> 5;
    for (int unit = c.b; unit < NCHUNK * 4; unit += gridDim.x) { const int ck = unit >> 2, hp = unit & 3, rb = ret_rowbase(ck);
#pragma unroll
        for (int q = 0; q < 4; ++q) { const int id = c.tid + NTHR * q; const int hl = id >> 10, m = (id >> 3) & 127, ch = id & 7, h = hp * 2 + hl;
            const bf16_t* src = P0 + (size_t)(rb + m) * 2816 + h * 64 + ch * 8;
            const u32x4 kw = *(const u32x4*)(src + 512), vw = *(const u32x4*)(src + 1024);
            const float zf = fexp2((float)(127 - m) * ld[h] * LOG2E), zb = fexp2((float)m * ld[8 + h] * LOG2E);
            u32x4 vf, vb;
#pragma unroll
            for (int k = 0; k < 4; ++k) { const float lo = bflo(vw[k]), hh = bfhi(vw[k]); vf[k] = pk2(lo * zf, hh * zf); vb[k] = pk2(lo * zb, hh * zb); }
            LAS unsigned char* base = c.lds + hl * 49152; const unsigned o = swzV(m, ch * 16);
            *(LAS u32x4*)(base + o) = kw; *(LAS u32x4*)(base + 16384 + o) = vf; *(LAS u32x4*)(base + 32768 + o) = vb; }
        __syncthreads();
        { const int hl = c.wid >> 2, dir = (c.wid >> 1) & 1, eblk = c.wid & 1, h = hp * 2 + hl;
          LAS const unsigned char* Kim = c.lds + hl * 49152; LAS const unsigned char* Vim = Kim + 16384 + dir * 16384;
          const int qrow = (c.lane & 15) >> 2, p = c.lane & 3, ebit = (c.lane >> 4) & 1;
          f32x16 acc[2]; acc[0] = (f32x16){}; acc[1] = (f32x16){};
#pragma unroll
          for (int ks = 0; ks < 8; ++ks) { const int m0 = 16 * ks + 4 * hi + qrow, m1 = m0 + 8;
              const s16x4 a0 = ldtr(Vim + swzV(m0, 64 * eblk + 32 * ebit + 8 * p)), a1 = ldtr(Vim + swzV(m1, 64 * eblk + 32 * ebit + 8 * p));
              const bf16x8 af = (bf16x8){a0[0], a0[1], a0[2], a0[3], a1[0], a1[1], a1[2], a1[3]};
#pragma unroll
              for (int db = 0; db < 2; ++db) { const s16x4 b0 = ldtr(Kim + swzV(m0, 64 * db + 32 * ebit + 8 * p)), b1 = ldtr(Kim + swzV(m1, 64 * db + 32 * ebit + 8 * p));
                  const bf16x8 bfr = (bf16x8){b0[0], b0[1], b0[2], b0[3], b1[0], b1[1], b1[2], b1[3]};
                  acc[db] = MFMA32(af, bfr, acc[db]); } }
          float* up = U + ((size_t)((dir * 8 + h) * NCHUNK + ck)) * 4096;
#pragma unroll
          for (int db = 0; db < 2; ++db)
#pragma unroll
              for (int r = 0; r < 16; ++r) up[(32 * eblk + crow(r, hi)) * 64 + 32 * db + r32] = acc[db][r]; }
        __syncthreads();
    }
}
__device__ __forceinline__ void ph_retscan(const Args& A, const Ctx& c) {
    if (c.tid >= 256) return;
    const float* U = WSP(float, WS_RETU); bf16_t* St = WSP(bf16_t, WS_RETS); const float* ld = A.in[9];
    const int idx = c.b * 256 + c.tid, dh = idx >> 12, el = idx & 4095, dir = dh >> 3;
    const float g = fexp2(128.f * ld[dh] * LOG2E);
    const float* up = U + (size_t)dh * NCHUNK * 4096 + el; bf16_t* sp = St + (size_t)dh * NCHUNK * 4096 + el;
    float s = 0.f;
#pragma unroll 26
    for (int i = 0; i < NCHUNK; ++i) { const int ck = dir == 0 ? i : (i == 0 ? 1 : (i == 1 ? 0 : 131 - i));
        const float u = up[(size_t)ck * 4096]; sp[(size_t)ck * 4096] = (bf16_t)(pk2(s, 0.f) & 0xffff); s = g * s + u; }
}
__device__ __forceinline__ void ph_ret2_unit(const Args& A, const Ctx& c, int unit) {
    const bf16_t* P0 = WSP(bf16_t, WS_P0); const bf16_t* St = WSP(bf16_t, WS_RETS); bf16_t* CAT = WSP(bf16_t, WS_CAT); const float* ld = A.in[9];
    const int r32 = c.lane & 31, hi = c.lane >> 5;
    const int ck = unit >> 2, hp = unit & 3, rb = ret_rowbase(ck);
    const int hl = c.wid >> 2, strip = c.wid & 3, h = hp * 2 + hl; const int cq = 32 * strip + r32, row = rb + cq;
    u32x4 kw[4], vw[4];
#pragma unroll
    for (int q = 0; q < 4; ++q) { const int id = c.tid + NTHR * q; const int hl2 = id >> 10, m = (id >> 3) & 127, ch = id & 7, h2 = hp * 2 + hl2;
        const bf16_t* src = P0 + (size_t)(rb + m) * 2816 + h2 * 64 + ch * 8; kw[q] = *(const u32x4*)(src + 512); vw[q] = *(const u32x4*)(src + 1024); }
    bf16x8 qf[4], sff[2][4], sbf[2][4]; u32x2 gw[2][4];
#pragma unroll
    for (int d0 = 0; d0 < 4; ++d0) qf[d0] = *(const bf16x8*)(P0 + (size_t)row * 2816 + h * 64 + d0 * 16 + hi * 8);
#pragma unroll
    for (int eb = 0; eb < 2; ++eb) { const bf16_t* sf = St + ((size_t)(h * NCHUNK + ck)) * 4096 + (32 * eb + r32) * 64 + hi * 8; const bf16_t* sb = sf + (size_t)8 * NCHUNK * 4096;
#pragma unroll
        for (int d0 = 0; d0 < 4; ++d0) { sff[eb][d0] = *(const bf16x8*)(sf + d0 * 16); sbf[eb][d0] = *(const bf16x8*)(sb + d0 * 16); }
#pragma unroll
        for (int rq = 0; rq < 4; ++rq) gw[eb][rq] = *(const u32x2*)(P0 + (size_t)row * 2816 + 1536 + h * 64 + 32 * eb + 8 * rq + 4 * hi); }
#pragma unroll
    for (int q = 0; q < 4; ++q) { const int id = c.tid + NTHR * q; const int hl2 = id >> 10, m = (id >> 3) & 127, ch = id & 7;
        LAS unsigned char* base = c.lds + hl2 * 34816;
        *(LAS u32x4*)(base + m * 144 + ch * 16) = kw[q]; *(LAS u32x4*)(base + 18432 + swzV(m, ch * 16)) = vw[q]; }
    __syncthreads();
    { LAS const unsigned char* Kim = c.lds + hl * 34816; LAS const unsigned char* Vim = Kim + 18432;
      const float lf2 = ld[h] * LOG2E, lb2 = ld[8 + h] * LOG2E;
      const float xf = fexp2((float)(cq + 1) * lf2), xb = fexp2((float)(128 - cq) * lb2);
      f32x16 o[2];
#pragma unroll
      for (int eb = 0; eb < 2; ++eb) {
          f32x16 t = (f32x16){};
#pragma unroll
          for (int d0 = 0; d0 < 4; ++d0) t = MFMA32(sff[eb][d0], qf[d0], t);
#pragma unroll
          for (int r = 0; r < 16; ++r) o[eb][r] = xf * t[r];
          t = (f32x16){};
#pragma unroll
          for (int d0 = 0; d0 < 4; ++d0) t = MFMA32(sbf[eb][d0], qf[d0], t);
#pragma unroll
          for (int r = 0; r < 16; ++r) o[eb][r] += xb * t[r]; }
      const int qrow = (c.lane & 15) >> 2, p = c.lane & 3, ebit = (c.lane >> 4) & 1;
#pragma unroll 1
      for (int blk = 0; blk < 4; ++blk) { f32x16 s = (f32x16){};
#pragma unroll
          for (int d0 = 0; d0 < 4; ++d0) s = MFMA32(*(const LAS bf16x8*)(Kim + (32 * blk + r32) * 144 + (2 * d0 + hi) * 16), qf[d0], s);
#pragma unroll
          for (int r = 0; r < 16; ++r) { const int dl = cq - (32 * blk + crow(r, hi));
              const float w = dl > 0 ? fexp2((float)dl * lf2) : (dl < 0 ? fexp2((float)(-dl) * lb2) : 2.f); s[r] *= w; }
#pragma unroll
          for (int half = 0; half < 2; ++half) { const int g = blk * 2 + half;
              u32x4 pw; pw.x = pk2(s[8 * half + 0], s[8 * half + 1]); pw.y = pk2(s[8 * half + 2], s[8 * half + 3]); pw.z = pk2(s[8 * half + 4], s[8 * half + 5]); pw.w = pk2(s[8 * half + 6], s[8 * half + 7]);
              const bf16x8 pf = __builtin_bit_cast(bf16x8, pw);
              const int m0 = 16 * g + 4 * hi + qrow, m1 = m0 + 8;
#pragma unroll
              for (int eb = 0; eb < 2; ++eb) { const s16x4 a0 = ldtr(Vim + swzV(m0, 64 * eb + 32 * ebit + 8 * p)), a1 = ldtr(Vim + swzV(m1, 64 * eb + 32 * ebit + 8 * p));
                  const bf16x8 af = (bf16x8){a0[0], a0[1], a0[2], a0[3], a1[0], a1[1], a1[2], a1[3]};
                  o[eb] = MFMA32(af, pf, o[eb]); } } }
      float sm = 0.f;
#pragma unroll
      for (int eb = 0; eb < 2; ++eb)
#pragma unroll
          for (int r = 0; r < 16; ++r) sm += o[eb][r];
      sm += xhalf(sm); const float mu = sm * (1.f / 64.f); float vq = 0.f;
#pragma unroll
      for (int eb = 0; eb < 2; ++eb)
#pragma unroll
          for (int r = 0; r < 16; ++r) { const float d = o[eb][r] - mu; vq += d * d; }
      vq += xhalf(vq); const float rs = rsqrtf(vq * (1.f / 64.f) + EPS);
#pragma unroll
      for (int eb = 0; eb < 2; ++eb)
#pragma unroll
          for (int rq = 0; rq < 4; ++rq) { const int e0 = 32 * eb + 8 * rq + 4 * hi; const u32x2 g2 = gw[eb][rq];
              const float y0 = (o[eb][4 * rq + 0] - mu) * rs * fsilu(bflo(g2.x)), y1 = (o[eb][4 * rq + 1] - mu) * rs * fsilu(bfhi(g2.x));
              const float y2 = (o[eb][4 * rq + 2] - mu) * rs * fsilu(bflo(g2.y)), y3 = (o[eb][4 * rq + 3] - mu) * rs * fsilu(bfhi(g2.y));
              u32x2 w; w.x = pk2(y0, y1); w.y = pk2(y2, y3); *(u32x2*)(CAT + (size_t)row * 1024 + h * 64 + e0) = w; } }
    __syncthreads();
}

__device__ __forceinline__ float max3f(float a, float b, float c) { return __builtin_fmaxf(__builtin_fmaxf(a, b), c); }
__device__ __forceinline__ float rowmax32(const f32x16& p0, const f32x16& p1) {
    float a = max3f(p0[0], p0[1], p1[0]), b = max3f(p0[2], p0[3], p1[1]); a = max3f(a, p1[2], p1[3]);
#pragma unroll
    for (int r = 4; r < 16; r += 4) { a = max3f(a, p0[r], p0[r + 1]); b = max3f(b, p0[r + 2], p0[r + 3]); a = max3f(a, p1[r], p1[r + 1]); b = max3f(b, p1[r + 2], p1[r + 3]); }
    float m; asm("v_max_f32_e32 %0, %1, %2" : "=v"(m) : "v"(a), "v"(b));
    auto rr = __builtin_amdgcn_permlane32_swap(__float_as_uint(m), __float_as_uint(m), false, false);
    float r2; asm("v_max_f32_e32 %0, %1, %2" : "=v"(r2) : "v"(__uint_as_float(rr[0])), "v"(__uint_as_float(rr[1]))); return r2;
}
__device__ __forceinline__ void glds16(const void* gsrc, unsigned lds_dst) { unsigned keep;
    asm volatile("s_mov_b32 %0, m0\n\ts_mov_b32 m0, %2\n\ts_nop 0\n\tglobal_load_lds_dwordx4 %1, off\n\ts_mov_b32 m0, %0" : "=&s"(keep) : "v"(gsrc), "s"(lds_dst) : "memory"); }
__device__ __forceinline__ float gain_sq(const float* g, int n, int lane) { float m = 0.f; for (int i = lane; i < n; i += 64) m = fmaxf(m, fabsf(g[i]));
#pragma unroll
    for (int o = 32; o >= 1; o >>= 1) m = fmaxf(m, __shfl_xor(m, o));
    return m * m * (float)n; }
struct AttnArgs { const bf16_t* Q; int qpitch; const bf16_t* K; int kpitch; const bf16_t* V; int vpitch; bf16_t* O; int opitch; int q0, key0, ntiles; bool rope; const float* g1; const float* g2; };
template <int MODE, bool FIXED>
__device__ __forceinline__ void attn_unit(const Ctx& c, const AttnArgs& a, float sbound) {
    constexpr int DQ = MODE == 0 ? 64 : 96, ND = DQ / 16, KP = DQ * 2 + 16, KB = 64 * KP, NKB = KB / 1024, CPR = DQ / 8;
    constexpr int KR = 0, VR = 3 * KB, DUM = VR + 3 * 8192;
    constexpr float SCALE = (MODE == 0 ? 0.125f : 0.10206207261596575f) * LOG2E, THR = 8.f;
    const int r32 = c.lane & 31, hi = c.lane >> 5; const int qrow = a.q0 + c.wid * 32 + r32;
    unsigned koff1, koff2, voff; const bool has2 = (8 + c.wid) < NKB;
    { const int o1 = 1024 * c.wid + 16 * c.lane, row1 = o1 / KP, ch1 = (o1 % KP) / 16; koff1 = (unsigned)(row1 * a.kpitch * 2 + (ch1 < CPR ? ch1 : 0) * 16);
      const int o2 = 1024 * (8 + c.wid) + 16 * c.lane, row2 = o2 / KP, ch2 = (o2 % KP) / 16; koff2 = has2 ? (unsigned)(row2 * a.kpitch * 2 + (ch2 < CPR ? ch2 : 0) * 16) : koff1;
      const int vrow = 8 * c.wid + (c.lane >> 3), pc = c.lane & 7, lc = pc ^ (4 * ((vrow >> 1) & 1)); voff = (unsigned)(vrow * a.vpitch * 2 + lc * 16); }
    const unsigned kd1 = (unsigned)(KR + 1024 * c.wid), kd2 = has2 ? (unsigned)(KR + 1024 * (8 + c.wid)) : 0u, vd = (unsigned)(VR + 1024 * c.wid);
    const int ntm1 = a.ntiles - 1; const unsigned lds0 = (unsigned)(uintptr_t)c.lds;
#define ATT_CL(x) ((x) < ntm1 ? (x) : ntm1)
#define ATT_DMAK(t, slot) do { const char* kb_ = (const char*)a.K + (size_t)(a.key0 + (t) * 64) * (size_t)(a.kpitch * 2); \
        glds16(kb_ + koff1, (unsigned)__builtin_amdgcn_readfirstlane(lds0 + kd1 + (unsigned)((slot) * KB))); \
        glds16(kb_ + koff2, (unsigned)__builtin_amdgcn_readfirstlane(lds0 + (has2 ? kd2 + (unsigned)((slot) * KB) : (unsigned)DUM))); } while (0)
#define ATT_DMAV(t, slot) do { const char* vb_ = (const char*)a.V + (size_t)(a.key0 + (t) * 64) * (size_t)(a.vpitch * 2); \
        glds16(vb_ + voff, (unsigned)__builtin_amdgcn_readfirstlane(lds0 + vd + (unsigned)((slot) * 8192))); } while (0)
#define ATT_WAITBAR(n) asm volatile("s_waitcnt vmcnt(" #n ") lgkmcnt(0)\n\ts_barrier" ::: "memory")
    bf16x8 qf[ND];
#pragma unroll
    for (int d0 = 0; d0 < ND; ++d0) qf[d0] = *(const bf16x8*)(a.Q + (size_t)qrow * a.qpitch + d0 * 16 + hi * 8);
    ATT_DMAK(0, 0); ATT_DMAV(0, 0); ATT_DMAK(ATT_CL(1), 1); ATT_DMAK(ATT_CL(2), 2); ATT_DMAV(ATT_CL(1), 1);
#define ATT_QK(dst, slot, cinit) do { LAS const unsigned char* Kt_ = c.lds + KR + (slot) * KB; dst##A = cinit; dst##B = cinit; \
        _Pragma("unroll") for (int d0 = 0; d0 < ND; ++d0) { const bf16x8 k0_ = *(const LAS bf16x8*)(Kt_ + r32 * KP + (2 * d0 + hi) * 16), k1_ = *(const LAS bf16x8*)(Kt_ + (32 + r32) * KP + (2 * d0 + hi) * 16); \
            dst##A = MFMA32(k0_, qf[d0], dst##A); dst##B = MFMA32(k1_, qf[d0], dst##B); } } while (0)
    ATT_WAITBAR(6);
    f32x16 sCA, sCB, sNA, sNB, negm; const f32x16 zero16 = (f32x16){};
    float m_run, l_run = 0.f, l_run2 = 0.f; f32x16 o[2]; o[0] = (f32x16){}; o[1] = (f32x16){};
    if (FIXED) {
        m_run = 0.f; negm = zero16;
        ATT_QK(sC, 0, zero16);
    } else {
        ATT_QK(sC, 0, zero16);
        const float mx = rowmax32(sCA, sCB); m_run = mx;
#pragma unroll
        for (int r = 0; r < 16; ++r) { sCA[r] -= mx; sCB[r] -= mx; negm[r] = -mx; } }
    ATT_WAITBAR(3);
    const int qrw = (c.lane & 15) >> 2, p = c.lane & 3, ebit = (c.lane >> 4) & 1;
    const unsigned vb0 = (unsigned)(4 * hi + qrw) * 128u + (unsigned)((32 * ebit + 8 * p) ^ (((qrw >> 1) & 1) * 64));
    const unsigned kfb = (unsigned)(r32 * KP + hi * 16);
    int r0 = 0, r1 = 1, r2 = 2;
    constexpr int NQ = 2 * ND, E1PER = FIXED ? 2 : 3, ELIM1 = FIXED ? 2 * NQ : (MODE == 0 ? 24 : 32), E2PER = FIXED ? (MODE == 0 ? 3 : 2) : 2;
#define SB() __builtin_amdgcn_sched_barrier(0)
#define ATT_STEP(SC, SN, t_) do { \
        ATT_DMAK(ATT_CL((t_) + 3), r0); ATT_DMAV(ATT_CL((t_) + 2), r2); \
        LAS const unsigned char* Kt_ = c.lds + KR + r1 * KB + kfb; LAS const unsigned char* Vt_ = c.lds + VR + r0 * 8192; \
        bf16x8 kf[NQ]; s16x4 va[8], vb[8]; u32x4 pw[4]; float psa = 0.f, psb = 0.f, ma = 0.f, mb = 0.f; int edone = 0, cdone = 0, mdone = 0; \
        kf[0] = *(const LAS bf16x8*)(Kt_); kf[1] = *(const LAS bf16x8*)(Kt_ + 32 * KP); \
        SB(); \
        _Pragma("unroll") for (int i = 0; i < NQ; ++i) { \
            if (i + 2 < NQ) kf[i + 2] = *(const LAS bf16x8*)(Kt_ + ((i + 2) & 1) * 32 * KP + ((i + 2) >> 1) * 32); \
            if (i + 2 == NQ) { va[0] = ldtr(Vt_ + vb0); vb[0] = ldtr(Vt_ + vb0 + 1024); } \
            if (i + 1 == NQ) { va[1] = ldtr(Vt_ + (vb0 ^ 64u)); vb[1] = ldtr(Vt_ + (vb0 ^ 64u) + 1024); } \
            if (i & 1) SN##B = MFMA32(kf[i], qf[i >> 1], i < 2 ? (FIXED ? zero16 : negm) : SN##B); else SN##A = MFMA32(kf[i], qf[i >> 1], i < 2 ? (FIXED ? zero16 : negm) : SN##A); \
            _Pragma("unroll") for (int k_ = 0; k_ < E1PER; ++k_) if (edone < ELIM1) { \
                if (edone < 16) { SC##A[edone & 15] = fexp2(SC##A[edone & 15]); if (edone & 1) psb += SC##A[edone & 15]; else psa += SC##A[edone & 15]; } \
                else            { SC##B[edone & 15] = fexp2(SC##B[edone & 15]); if (edone & 1) psb += SC##B[edone & 15]; else psa += SC##B[edone & 15]; } ++edone; } \
            _Pragma("unroll") for (int k_ = 0; k_ < 2; ++k_) if (i >= 3 && cdone < 16 && 2 * cdone + 1 < edone) { const int g_ = cdone >> 2, q_ = cdone & 3, e_ = 8 * (g_ & 1) + 2 * q_; \
                pw[g_][q_] = g_ < 2 ? pk2(SC##A[e_], SC##A[e_ + 1]) : pk2(SC##B[e_], SC##B[e_ + 1]); ++cdone; } \
            asm volatile("" : "+v"(psa), "+v"(psb)); \
            SB(); } \
        _Pragma("unroll") for (int j = 0; j < 8; ++j) { const int g_ = j >> 1, eb_ = j & 1; \
            if (j + 2 < 8) { LAS const unsigned char* vp_ = Vt_ + (vb0 ^ (unsigned)(64 * ((j + 2) & 1))) + ((j + 2) >> 1) * 2048; va[j + 2] = ldtr(vp_); vb[j + 2] = ldtr(vp_ + 1024); } \
            _Pragma("unroll") for (int k_ = 0; k_ < E2PER; ++k_) if (edone < 32) { \
                SC##B[edone & 15] = fexp2(SC##B[edone & 15]); if (edone & 1) psb += SC##B[edone & 15]; else psa += SC##B[edone & 15]; ++edone; } \
            _Pragma("unroll") for (int k_ = 0; k_ < 4; ++k_) if (cdone < 16 && 2 * cdone + 1 < edone && (cdone >> 2) <= g_ + 1) { const int g2_ = cdone >> 2, q_ = cdone & 3, e_ = 8 * (g2_ & 1) + 2 * q_; \
                pw[g2_][q_] = g2_ < 2 ? pk2(SC##A[e_], SC##A[e_ + 1]) : pk2(SC##B[e_], SC##B[e_ + 1]); ++cdone; } \
            { const bf16x8 af_ = (bf16x8){va[j][0], va[j][1], va[j][2], va[j][3], vb[j][0], vb[j][1], vb[j][2], vb[j][3]}; \
              o[eb_] = MFMA32(af_, __builtin_bit_cast(bf16x8, pw[g_]), o[eb_]); } \
            _Pragma("unroll") for (int k_ = 0; k_ < 3; ++k_) if (!FIXED && j >= 2 && mdone < 15) {   \
                if (mdone == 0) ma = max3f(SN##A[0], SN##A[1], SN##B[0]); else if (mdone == 1) mb = max3f(SN##A[2], SN##A[3], SN##B[1]); else if (mdone == 2) ma = max3f(ma, SN##B[2], SN##B[3]); \
                else { const int r_ = 4 + 4 * ((mdone - 3) >> 2), w_ = (mdone - 3) & 3; \
                    if (w_ == 0) ma = max3f(ma, SN##A[r_], SN##A[r_ + 1]); else if (w_ == 1) mb = max3f(mb, SN##A[r_ + 2], SN##A[r_ + 3]); else if (w_ == 2) ma = max3f(ma, SN##B[r_], SN##B[r_ + 1]); else mb = max3f(mb, SN##B[r_ + 2], SN##B[r_ + 3]); } \
                ++mdone; } \
            asm volatile("" : "+v"(psa), "+v"(psb)); \
            SB(); } \
        l_run += psa; l_run2 += psb; \
        float mx_ = 0.f; if (!FIXED) { mx_ = fmaxf(ma, mb); auto rr_ = __builtin_amdgcn_permlane32_swap(__float_as_uint(mx_), __float_as_uint(mx_), false, false); mx_ = fmaxf(__uint_as_float(rr_[0]), __uint_as_float(rr_[1])); } \
        ATT_WAITBAR(3); \
        { const int tmp_ = r0; r0 = r1; r1 = r2; r2 = tmp_; } \
        if (!FIXED && __builtin_expect(__any(mx_ > THR), 0)) { const float dl = fmaxf(mx_, 0.f); const float al = fexp2(-dl); m_run += dl; l_run *= al; l_run2 *= al; o[0] = o[0] * al; o[1] = o[1] * al; \
            _Pragma("unroll") for (int r = 0; r < 16; ++r) { SN##A[r] -= dl; SN##B[r] -= dl; negm[r] -= dl; } } \
        if (!FIXED) asm volatile("" : "+v"(negm)); \
    } while (0)
    for (int t = 0; t < a.ntiles; t += 2) {
        ATT_STEP(sC, sN, t);
        ATT_STEP(sN, sC, t + 1);
    }
    l_run += l_run2;
#undef SB
    ATT_WAITBAR(0);
    l_run += xhalf(l_run); const float il = 1.f / l_run;
#pragma unroll
    for (int eb = 0; eb < 2; ++eb)
#pragma unroll
        for (int rq = 0; rq < 4; ++rq) { const int e0 = 32 * eb + 8 * rq + 4 * hi;
            u32x2 w; w.x = pk2(o[eb][4 * rq] * il, o[eb][4 * rq + 1] * il); w.y = pk2(o[eb][4 * rq + 2] * il, o[eb][4 * rq + 3] * il);
            *(u32x2*)(a.O + (size_t)qrow * a.opitch + e0) = w; }
#undef ATT_STEP
#undef ATT_CL
#undef ATT_DMAK
#undef ATT_DMAV
#undef ATT_WAITBAR
#undef ATT_QK
}
template <int MODE>
__device__ __forceinline__ void att_qprep(const AttnArgs& a, const float2* T, int qrow, int hi, bf16x8 (&qf)[MODE == 0 ? 4 : 6]) {
    constexpr int DQ = MODE == 0 ? 64 : 96, ND = DQ / 16; constexpr float SCALE = (MODE == 0 ? 0.125f : 0.10206207261596575f) * LOG2E;
    float x[ND][8];
#pragma unroll
    for (int d0 = 0; d0 < ND; ++d0) { const u32x4 w = *(const u32x4*)(a.Q + (size_t)qrow * a.qpitch + d0 * 16 + hi * 8);
#pragma unroll
        for (int k = 0; k < 4; ++k) { x[d0][2 * k] = bflo(w[k]); x[d0][2 * k + 1] = bfhi(w[k]); } }
    float ss = 0.f;
#pragma unroll
    for (int d0 = 0; d0 < 4; ++d0)
#pragma unroll
        for (int k = 0; k < 8; ++k) ss += x[d0][k] * x[d0][k];
    ss += xhalf(ss); const float rs = rsqrtf(ss * (1.f / 64.f) + EPS);
#pragma unroll
    for (int d0 = 0; d0 < 4; ++d0)
#pragma unroll
        for (int k = 0; k < 8; ++k) x[d0][k] *= rs * a.g1[d0 * 16 + hi * 8 + k];
    const int qr = a.rope ? qrow : 0, pr = qr / 64, pc = qr % 64;
    if (MODE == 0) {
#pragma unroll
        for (int d0 = 0; d0 < 4; ++d0)
#pragma unroll
            for (int k = 0; k < 4; ++k) { const int i = 8 * d0 + 4 * hi + k; float2 cs = T[(i < 16 ? pr : pc) * 16 + (i & 15)]; if (!a.rope) cs = make_float2(1.f, 0.f);
                const float a0 = x[d0][2 * k] * cs.x - x[d0][2 * k + 1] * cs.y, b0 = x[d0][2 * k] * cs.y + x[d0][2 * k + 1] * cs.x; x[d0][2 * k] = a0; x[d0][2 * k + 1] = b0; } }
    else { float s2 = 0.f;
#pragma unroll
        for (int d0 = 4; d0 < ND; ++d0)
#pragma unroll
            for (int k = 0; k < 8; ++k) s2 += x[d0][k] * x[d0][k];
        s2 += xhalf(s2); const float r2 = rsqrtf(s2 * (1.f / 32.f) + EPS);
#pragma unroll
        for (int d0 = 4; d0 < ND; ++d0) {
#pragma unroll
            for (int k = 0; k < 8; ++k) x[d0][k] *= r2 * a.g2[(d0 - 4) * 16 + hi * 8 + k];
#pragma unroll
            for (int k = 0; k < 4; ++k) { const int i = 8 * (d0 - 4) + 4 * hi + k; rope_pair(x[d0][2 * k], x[d0][2 * k + 1], T, i < 8 ? pr : pc, 2 * (i & 7)); } } }
#pragma unroll
    for (int d0 = 0; d0 < ND; ++d0) { u32x4 w;
#pragma unroll
        for (int k = 0; k < 4; ++k) w[k] = pk2(x[d0][2 * k] * SCALE, x[d0][2 * k + 1] * SCALE);
        qf[d0] = __builtin_bit_cast(bf16x8, w); }
}
template <int MODE>
__device__ __forceinline__ void ph_qprep(const Ctx& c, bf16_t* Qbase, int pitch, int nrows, const float* g1, const float* g2, const float2* T) {
    constexpr int DQ = MODE == 0 ? 64 : 96, ND = DQ / 16;
    const int r32 = c.lane & 31, hi = c.lane >> 5;
    for (int task = c.b * 8 + c.wid; task < (nrows / 32) * 8; task += gridDim.x * 8) { const int rb = task >> 3, h = task & 7; const int qrow = rb * 32 + r32;
        AttnArgs a{Qbase + h * DQ, pitch, nullptr, 0, nullptr, 0, nullptr, 0, 0, 0, 0, qrow < SEQ, g1, g2};
        bf16x8 qf[ND]; att_qprep<MODE>(a, T, qrow, hi, qf);
#pragma unroll
        for (int d0 = 0; d0 < ND; ++d0) *(bf16x8*)(Qbase + (size_t)qrow * pitch + h * DQ + d0 * 16 + hi * 8) = qf[d0]; }
}
template <int MODE>
__device__ __forceinline__ void attn64_unit(const Ctx& c, const AttnArgs& a, int rows_valid) {
    constexpr int DQ = MODE == 0 ? 64 : 96, ND = DQ / 16, KP = DQ * 2 + 16, KB = 64 * KP, NKB = KB / 1024, CPR = DQ / 8;
    constexpr int KR = 0, VR = 3 * KB, DUM = VR + 3 * 8192;
    const int r32 = c.lane & 31, hi = c.lane >> 5; const int rl = c.wid * 64 + r32; const bool live = rl < rows_valid;
    const int qrowA = a.q0 + (live ? rl : r32), qrowB = qrowA + 32;
    bf16x8 qfA[ND], qfB[ND];
#pragma unroll
    for (int d0 = 0; d0 < ND; ++d0) { qfA[d0] = *(const bf16x8*)(a.Q + (size_t)qrowA * a.qpitch + d0 * 16 + hi * 8); qfB[d0] = *(const bf16x8*)(a.Q + (size_t)qrowB * a.qpitch + d0 * 16 + hi * 8); }
#pragma unroll
    for (int d0 = 0; d0 < ND; ++d0) asm volatile("" :: "v"(qfA[d0]), "v"(qfB[d0]));
    unsigned koff1, koff2, voff; const bool has2 = (8 + c.wid) < NKB;
    { const int o1 = 1024 * c.wid + 16 * c.lane, row1 = o1 / KP, ch1 = (o1 % KP) / 16; koff1 = (unsigned)(row1 * a.kpitch * 2 + (ch1 < CPR ? ch1 : 0) * 16);
      const int o2 = 1024 * (8 + c.wid) + 16 * c.lane, row2 = o2 / KP, ch2 = (o2 % KP) / 16; koff2 = has2 ? (unsigned)(row2 * a.kpitch * 2 + (ch2 < CPR ? ch2 : 0) * 16) : koff1;
      const int vrow = 8 * c.wid + (c.lane >> 3), pc = c.lane & 7, lc = pc ^ (4 * ((vrow >> 1) & 1)); voff = (unsigned)(vrow * a.vpitch * 2 + lc * 16); }
    const unsigned kd1 = (unsigned)(KR + 1024 * c.wid), kd2 = has2 ? (unsigned)(KR + 1024 * (8 + c.wid)) : 0u, vd = (unsigned)(VR + 1024 * c.wid);
    const int ntm1 = a.ntiles - 1; const unsigned lds0 = (unsigned)(uintptr_t)c.lds;
#define A64_CL(x) ((x) < ntm1 ? (x) : ntm1)
#define A64_DMAK(t, slot) do { const char* kb_ = (const char*)a.K + (size_t)(a.key0 + (t) * 64) * (size_t)(a.kpitch * 2); \
        glds16(kb_ + koff1, (unsigned)__builtin_amdgcn_readfirstlane(lds0 + kd1 + (unsigned)((slot) * KB))); \
        glds16(kb_ + koff2, (unsigned)__builtin_amdgcn_readfirstlane(lds0 + (has2 ? kd2 + (unsigned)((slot) * KB) : (unsigned)DUM))); } while (0)
#define A64_DMAV(t, slot) do { const char* vb_ = (const char*)a.V + (size_t)(a.key0 + (t) * 64) * (size_t)(a.vpitch * 2); \
        glds16(vb_ + voff, (unsigned)__builtin_amdgcn_readfirstlane(lds0 + vd + (unsigned)((slot) * 8192))); } while (0)
#define A64_WAITBAR(n) asm volatile("s_waitcnt vmcnt(" #n ") lgkmcnt(0)\n\ts_barrier" ::: "memory")
    A64_DMAK(0, 0); A64_DMAV(0, 0); A64_DMAK(A64_CL(1), 1); A64_DMAV(A64_CL(1), 1);
    A64_WAITBAR(3);
    f32x16 oA[2], oB[2]; oA[0] = (f32x16){}; oA[1] = (f32x16){}; oB[0] = (f32x16){}; oB[1] = (f32x16){};
    float lA = 0.f, lA2 = 0.f, lB = 0.f, lB2 = 0.f;
    const int qrw = (c.lane & 15) >> 2, p = c.lane & 3, ebit = (c.lane >> 4) & 1;
    const unsigned vb0 = (unsigned)(4 * hi + qrw) * 128u + (unsigned)((32 * ebit + 8 * p) ^ (((qrw >> 1) & 1) * 64));
    const unsigned kfb = (unsigned)(r32 * KP + hi * 16);
    int r0 = 0, r2 = 2;
    for (int t = 0; t < a.ntiles; ++t) {
        LAS const unsigned char* Kt = c.lds + KR + r0 * KB + kfb; LAS const unsigned char* Vt = c.lds + VR + r0 * 8192;
        const bf16x8 kp0 = *(const LAS bf16x8*)(Kt), kp1 = *(const LAS bf16x8*)(Kt + 32 * KP);
        A64_DMAK(A64_CL(t + 2), r2); A64_DMAV(A64_CL(t + 2), r2);
        f32x16 sA0 = (f32x16){}, sA1 = (f32x16){}, sB0 = (f32x16){}, sB1 = (f32x16){};
#pragma unroll
        for (int d0 = 0; d0 < ND; ++d0) { const bf16x8 k0 = d0 == 0 ? kp0 : *(const LAS bf16x8*)(Kt + d0 * 32), k1 = d0 == 0 ? kp1 : *(const LAS bf16x8*)(Kt + 32 * KP + d0 * 32);
            sA0 = MFMA32(k0, qfA[d0], sA0); sB0 = MFMA32(k0, qfB[d0], sB0); sA1 = MFMA32(k1, qfA[d0], sA1); sB1 = MFMA32(k1, qfB[d0], sB1); }
        u32x4 pwA[4], pwB[4];
#pragma unroll
        for (int r = 0; r < 16; r += 2) { sA0[r] = fexp2(sA0[r]); sA0[r + 1] = fexp2(sA0[r + 1]); lA += sA0[r]; lA2 += sA0[r + 1]; pwA[r >> 3][(r >> 1) & 3] = pk2(sA0[r], sA0[r + 1]); }
#pragma unroll
        for (int r = 0; r < 16; r += 2) { sB0[r] = fexp2(sB0[r]); sB0[r + 1] = fexp2(sB0[r + 1]); lB += sB0[r]; lB2 += sB0[r + 1]; pwB[r >> 3][(r >> 1) & 3] = pk2(sB0[r], sB0[r + 1]); }
#pragma unroll
        for (int r = 0; r < 16; r += 2) { sA1[r] = fexp2(sA1[r]); sA1[r + 1] = fexp2(sA1[r + 1]); lA += sA1[r]; lA2 += sA1[r + 1]; pwA[2 + (r >> 3)][(r >> 1) & 3] = pk2(sA1[r], sA1[r + 1]); }
#pragma unroll
        for (int r = 0; r < 16; r += 2) { sB1[r] = fexp2(sB1[r]); sB1[r + 1] = fexp2(sB1[r + 1]); lB += sB1[r]; lB2 += sB1[r + 1]; pwB[2 + (r >> 3)][(r >> 1) & 3] = pk2(sB1[r], sB1[r + 1]); }
#pragma unroll
        for (int g = 0; g < 4; ++g)
#pragma unroll
            for (int eb = 0; eb < 2; ++eb) { LAS const unsigned char* vp = Vt + (vb0 ^ (unsigned)(64 * eb)) + g * 2048;
                const s16x4 a0 = ldtr(vp), a1 = ldtr(vp + 1024);
                const bf16x8 af = (bf16x8){a0[0], a0[1], a0[2], a0[3], a1[0], a1[1], a1[2], a1[3]};
                oA[eb] = MFMA32(af, __builtin_bit_cast(bf16x8, pwA[g]), oA[eb]); oB[eb] = MFMA32(af, __builtin_bit_cast(bf16x8, pwB[g]), oB[eb]); }
        A64_WAITBAR(3);
        r0 = r0 == 2 ? 0 : r0 + 1; r2 = r0 == 0 ? 2 : r0 - 1;
    }
    A64_WAITBAR(0);
    lA += lA2; lB += lB2; lA += xhalf(lA); lB += xhalf(lB); const float ilA = 1.f / lA, ilB = 1.f / lB;
    if (live) {
#pragma unroll
        for (int eb = 0; eb < 2; ++eb)
#pragma unroll
            for (int rq = 0; rq < 4; ++rq) { const int e0 = 32 * eb + 8 * rq + 4 * hi;
                u32x2 w; w.x = pk2(oA[eb][4 * rq] * ilA, oA[eb][4 * rq + 1] * ilA); w.y = pk2(oA[eb][4 * rq + 2] * ilA, oA[eb][4 * rq + 3] * ilA);
                *(u32x2*)(a.O + (size_t)qrowA * a.opitch + e0) = w;
                u32x2 v; v.x = pk2(oB[eb][4 * rq] * ilB, oB[eb][4 * rq + 1] * ilB); v.y = pk2(oB[eb][4 * rq + 2] * ilB, oB[eb][4 * rq + 3] * ilB);
                *(u32x2*)(a.O + (size_t)qrowB * a.opitch + e0) = v; } }
#undef A64_CL
#undef A64_DMAK
#undef A64_DMAV
#undef A64_WAITBAR
}
}
namespace mk {
constexpr int NPH = 22;
constexpr int ROWTAB_OFF = 131072, BARW_OFF = 131072 + 16384, LDS_BYTES = BARW_OFF + 64;
#ifndef MK_PER_PHASE
#define MK_PER_PHASE 0
#endif

__global__ void __launch_bounds__(512, 2) mk_fwd(Args A) {
    extern __shared__ __attribute__((aligned(16))) unsigned char smem[];
    Ctx c; c.a = &A; c.lds = (LAS unsigned char*)smem; c.tid = threadIdx.x; c.lane = c.tid & 63; c.wid = __builtin_amdgcn_readfirstlane(c.tid >> 6); c.b = blockIdx.x;
    if (c.tid == 0) *(LAS u32x4*)(c.lds + BARW_OFF) = (u32x4){0u, 0u, 0u, 0u};
    __syncthreads();
    XcdBarrier bar; bar.bar = WSP(unsigned, WS_BAR); bar.x = 0; bar.st = (volatile LAS unsigned*)(c.lds + BARW_OFF);
    if (A.ph_hi - A.ph_lo > 1) bar = xcd_barrier_post(WSP(unsigned, WS_BAR), (volatile LAS unsigned*)(c.lds + BARW_OFF));
#ifdef MK_ONLY
#define IN(k) ((k) == MK_ONLY)
#else
#define IN(k) (A.ph_lo <= (k) && (k) < A.ph_hi)
#endif
#ifndef MK_DUPMASK
#define MK_DUPMASK 0u
#endif
#define REPS(k) for (int rep_ = 0; rep_ < 1 + (int)((MK_DUPMASK >> (k)) & 1u); ++rep_)
#define SEAM(k) do { if (IN(k) && IN((k) + 1)) xcd_barrier(bar); } while (0)
    const int G = gridDim.x;
    float* mod0l = WSP(float, WS_MOD); float* mod0c = mod0l + 6144; float* mod1l = mod0l + 2 * 6144; float* mod1c = mod0l + 3 * 6144;
    float* ctxs = WSP(float, WS_CTXS);

    if (IN(0)) REPS(0) { ph_rope_table(A, c); ph_ada(A, c); }
    const bool flag01 = IN(0) && IN(1);
    if (flag01) ada_signal(A, c);
    if (IN(1)) REPS(1) { ph_convert(A, c); if (flag01) ada_wait(A, c); ph_modulate<true, false>(A, c, A.in[0], A.in[2], A.in[6], mod0l, mod0c, 0, 1); }
    SEAM(1);
    if (IN(2)) REPS(2) { pg8::Gemm g{WSP(bf16_t, WS_XN), WSP(bf16_t, WS_W0IN), 1024, 1024, nullptr, 1024}; pg8::StaticOrder S; S.init(65, 11, G, c.b);
        pg8::EpiStore E{WSP(bf16_t, WS_P0), 2816}; pg8::gemm_phase<pg8::EpiStore, pg8::StaticOrder, true>(c.lds, g, S, E); }
    SEAM(2);
    if (IN(3)) REPS(3) { ph_ret1(A, c); ph_qprep<0>(c, WSP(bf16_t, WS_P0) + 2048, 2816, ROWS, A.in[10], nullptr, WSP(float2, WS_ROPE)); ph_kprep0(A, c); }
    SEAM(3);
    if (IN(4)) REPS(4) ph_retscan(A, c);
    SEAM(4);
    if (IN(5)) REPS(5) {
        for (int rr_ = 0; rr_ < 1 + (int)((MK_DUPMASK >> 22) & 1u); ++rr_) for (int u = c.b; u < NCHUNK * 4; u += G) ph_ret2_unit(A, c, u);
        const bf16_t* P0 = WSP(bf16_t, WS_P0);
        const float sb0 = 1.02f * sqrtf(gain_sq(A.in[10], 64, c.lane) * gain_sq(A.in[11], 64, c.lane)) * 0.125f * LOG2E; const bool fix0 = sb0 < 40.f;
        if (fix0) { { const int head = c.b & 7, qb = c.b >> 3;
                AttnArgs a{P0 + 2048 + head * 64, 2816, WSP(bf16_t, WS_KP) + (head >> 2) * 64, 128, P0 + 2688 + (head >> 2) * 64, 2816, WSP(bf16_t, WS_CAT) + 512 + head * 64, 1024, qb * 512, 0, 260, true, A.in[10], nullptr};
                attn64_unit<0>(c, a, 512); }
            if (c.b >= 8 && c.b < 16) { const int head = c.b - 8;
                AttnArgs a{P0 + 2048 + head * 64, 2816, WSP(bf16_t, WS_KP) + (head >> 2) * 64, 128, P0 + 2688 + (head >> 2) * 64, 2816, WSP(bf16_t, WS_CAT) + 512 + head * 64, 1024, SEQ, SEQ, 4, false, A.in[10], nullptr};
                attn64_unit<0>(c, a, 256); }
        } else {
        for (int i = 0; i < 2; ++i) { const int head = c.b & 7, qb = (c.b >> 3) + 32 * i;
            AttnArgs a{P0 + 2048 + head * 64, 2816, WSP(bf16_t, WS_KP) + (head >> 2) * 64, 128, P0 + 2688 + (head >> 2) * 64, 2816, WSP(bf16_t, WS_CAT) + 512 + head * 64, 1024, qb * 256, 0, 260, true, A.in[10], nullptr};
            attn_unit<0, false>(c, a, sb0); }
        if (c.b >= 8 && c.b < 16) { const int head = c.b - 8;
            AttnArgs a{P0 + 2048 + head * 64, 2816, WSP(bf16_t, WS_KP) + (head >> 2) * 64, 128, P0 + 2688 + (head >> 2) * 64, 2816, WSP(bf16_t, WS_CAT) + 512 + head * 64, 1024, SEQ, SEQ, 4, false, A.in[10], nullptr};
            attn_unit<0, false>(c, a, sb0); }
        }
    }
    SEAM(5);
    if (IN(6)) REPS(6) { for (int rr_ = 0; rr_ < 1 + (int)((MK_DUPMASK >> 23) & 1u); ++rr_) ctx_gemm_resid(c, WSP(bf16_t, WS_CAT) + (size_t)SEQ * 1024, 1024, WSP(bf16_t, WS_W0OUT), 1024, A.in[2], ctxs, mod0c + 2 * DM);
        pg8::Gemm g{WSP(bf16_t, WS_CAT), WSP(bf16_t, WS_W0OUT), 1024, 1024, nullptr, 1024}; pg8::StaticOrder S; S.init(64, 4, G, c.b);
        pg8::EpiResidB E{A.in[0], nullptr, WSP(bf16_t, WS_XB), mod0l + 2 * DM, 1.f}; pg8::gemm_phase<pg8::EpiResidB, pg8::StaticOrder, false>(c.lds, g, S, E); }
    SEAM(6);
    if (IN(7)) REPS(7) ph_modulate<true, false, true>(A, c, (const float*)WSP(bf16_t, WS_XB), ctxs, A.in[7], mod0l, mod0c, 3, 4);
    SEAM(7);
    if (IN(8)) REPS(8) { pg8::Gemm g{WSP(bf16_t, WS_XN), WSP(bf16_t, WS_W013), 1024, 1024, nullptr, 1024}; pg8::StaticOrder S; S.init(65, 22, G, c.b);
        pg8::EpiSwiglu E{WSP(bf16_t, WS_P0), 2816, 1.f}; pg8::gemm_phase<pg8::EpiSwiglu, pg8::StaticOrder, true>(c.lds, g, S, E); }
    SEAM(8);
    if (IN(9)) REPS(9) { ctx_gemm_resid(c, WSP(bf16_t, WS_P0) + (size_t)SEQ * 2816, 2816, WSP(bf16_t, WS_W02), 2816, ctxs, ctxs, mod0c + 5 * DM);
        pg8::Gemm g{WSP(bf16_t, WS_P0), WSP(bf16_t, WS_W02), 2816, 2816, nullptr, 2816}; pg8::StaticOrder S; S.init(64, 4, G, c.b);
        pg8::EpiResidB E{nullptr, WSP(bf16_t, WS_XB), WSP(bf16_t, WS_XB), mod0l + 5 * DM, 1.f}; pg8::gemm_phase<pg8::EpiResidB, pg8::StaticOrder, false>(c.lds, g, S, E); }
    SEAM(9);
    if (IN(10)) REPS(10) ph_modulate<true, false, true>(A, c, (const float*)WSP(bf16_t, WS_XB), ctxs, A.in[18], mod1l, mod1c, 0, 1);
    SEAM(10);
    if (IN(11)) REPS(11) { pg8::Gemm g{WSP(bf16_t, WS_XN), WSP(bf16_t, WS_W1IN), 1024, 1024, nullptr, 1024}; pg8::StaticOrder S; S.init(65, 3, G, c.b);
        pg8::EpiStore E{WSP(bf16_t, WS_P1), 768}; pg8::gemm_phase<pg8::EpiStore, pg8::StaticOrder, true>(c.lds, g, S, E); }
    SEAM(11);
    if (IN(12)) REPS(12) ph_prep1a(A, c);
    SEAM(12);
    if (IN(13)) REPS(13) {
        { pg8::Gemm g{WSP(bf16_t, WS_P1), WSP(bf16_t, WS_W1UQ), 384, 768, nullptr, 384}; pg8::StaticOrder S; S.init(64, 3, G, c.b);
          pg8::EpiStore E{WSP(bf16_t, WS_Q1), 768}; pg8::gemm_phase<pg8::EpiStore, pg8::StaticOrder, true>(c.lds, g, S, E); }
        { pg8::Gemm g{WSP(bf16_t, WS_P1) + 384, WSP(bf16_t, WS_W1UKV), 256, 768, nullptr, 256}; pg8::StaticOrder S; S.init(65, 4, G, (c.b + 64) & 255);
          pg8::EpiStore E{WSP(bf16_t, WS_KV1), 1024}; pg8::gemm_phase<pg8::EpiStore, pg8::StaticOrder, true>(c.lds, g, S, E); }
    }
    SEAM(13);
    if (IN(14)) REPS(14) { ph_qprep<1>(c, WSP(bf16_t, WS_Q1), 768, SEQ, A.in[25], A.in[26], WSP(float2, WS_ROPE)); ph_prep1b(A, c); }
    SEAM(14);
    if (IN(15)) REPS(15) {
        const float sb1 = 1.02f * sqrtf((gain_sq(A.in[25], 64, c.lane) + gain_sq(A.in[26], 32, c.lane)) * (gain_sq(A.in[27], 64, c.lane) + gain_sq(A.in[28], 32, c.lane))) * 0.10206207261596575f * LOG2E; const bool fix1 = sb1 < 40.f;
        if (fix1) { const int head = c.b & 7, qb = c.b >> 3;
            AttnArgs a{WSP(bf16_t, WS_Q1) + head * 96, 768, WSP(bf16_t, WS_K1) + head * 96, 768, WSP(bf16_t, WS_KV1) + head * 128 + 64, 1024, WSP(bf16_t, WS_O1) + head * 64, 512, qb * 512, 0, 260, true, A.in[25], A.in[26]};
            attn64_unit<1>(c, a, 512);
        } else {
        for (int i = 0; i < 2; ++i) { const int head = c.b & 7, qb = (c.b >> 3) + 32 * i;
            AttnArgs a{WSP(bf16_t, WS_Q1) + head * 96, 768, WSP(bf16_t, WS_K1) + head * 96, 768, WSP(bf16_t, WS_KV1) + head * 128 + 64, 1024, WSP(bf16_t, WS_O1) + head * 64, 512, qb * 256, 0, 260, true, A.in[25], A.in[26]};
            attn_unit<1, false>(c, a, sb1); }
        }
    }
    SEAM(15);
    if (IN(16)) REPS(16) { pg8::Gemm g{WSP(bf16_t, WS_O1), WSP(bf16_t, WS_W1OUT), 512, 512, nullptr, 512}; pg8::StaticOrder S; S.init(64, 4, G, c.b);
        pg8::EpiResidB E{nullptr, WSP(bf16_t, WS_XB), WSP(bf16_t, WS_XB), mod1l + 2 * DM, 1.f}; pg8::gemm_phase<pg8::EpiResidB, pg8::StaticOrder, false>(c.lds, g, S, E); }
    SEAM(16);
    if (IN(17)) REPS(17) ph_modulate<false, true, true>(A, c, (const float*)WSP(bf16_t, WS_XB), ctxs, A.in[19], mod1l, mod1c, 3, 4);
    SEAM(17);
    if (IN(18)) REPS(18) ph_plan(A, c);
    SEAM(18);
    if (IN(19)) REPS(19) { const int ntiles = WSP(int, WS_TILE)[255];
        pg8::MoeOrder S; S.so.init(ntiles, 28, G, c.b); S.tile_e = WSP(int, WS_TILE);
        LAS unsigned* rowtab = (LAS unsigned*)(c.lds + ROWTAB_OFF); const unsigned* rowt = WSP(unsigned, WS_ROWT);
        { pg8::Unit u; for (int i = 0; i < 16 && S.next(i, u); ++i) if (c.tid < 256) rowtab[i * 256 + c.tid] = rowt[u.pm * 256 + c.tid]; }
        __syncthreads();
        pg8::Gemm g{WSP(bf16_t, WS_XN), WSP(bf16_t, WS_WE13), 512, 512, rowtab, 512};
        pg8::EpiSwigluQ8 E{WSP(unsigned char, WS_HM), 3584, 1.f / 64.f}; pg8::gemm_phase<pg8::EpiSwigluQ8, pg8::MoeOrder, true, true>(c.lds, g, S, E); }
    SEAM(19);
    if (IN(20)) REPS(20) { const int ntiles = WSP(int, WS_TILE)[255]; const int U = ntiles * 4; int F = (U / G) * G, R = U - F; int S = R <= 18 ? 14 : 7; if (R > 36 || R == 0) { F = U; R = 0; }
        pg8::Gemm g{WSP(bf16_t, WS_HM), WSP(bf16_t, WS_WE2), 1792, 1792, nullptr, 1792};
        { const int Ks = 1792 / S; pg8::MoeDownAll S1; S1.so.init(F >> 2, 4, G, c.b); S1.tile_e = WSP(int, WS_TILE); S1.F = F; S1.R = R; S1.S = S; S1.Ks = Ks; S1.c = c.b; S1.nw = F / G; S1.ntw = 28; S1.nts = Ks / 64;
          pg8::EpiDownAll E{WSP(bf16_t, WS_Y), 1024, 1.f / 64.f, WSP(float, WS_PART)};
          pg8::gemm_phase<pg8::EpiDownAll, pg8::MoeDownAll, true, true, true>(c.lds, g, S1, E);
          if (R > 0 && c.b < R * S) moe_split_fixup(A, c, F, S); } }
    SEAM(20);
    if (IN(21)) REPS(21) ph_combine(A, c);
#undef IN
#undef SEAM
}
}

extern "C" void kernel_launch(void* const* d_in, const int* in_sizes, int n_in, void* d_out, int out_size, void* d_ws, size_t ws_size, hipStream_t stream) {
    static int ready = 0;
    if (!ready) {
        if (hipFuncSetAttribute((const void*)mk::mk_fwd, hipFuncAttributeMaxDynamicSharedMemorySize, mk::LDS_BYTES) != hipSuccess) { fprintf(stderr, "hipFuncSetAttribute failed\n"); }
        if (ws_size < mk::WS_END) fprintf(stderr, "kernel_launch: workspace too small: %zu < %zu\n", ws_size, (size_t)mk::WS_END);
        (void)hipGetLastError();
        ready = 1;
    }
    (void)hipMemsetAsync((char*)d_ws + mk::WS_BAR, 0, 16384, stream);
    mk::Args a{};
    for (int i = 0; i < 34; ++i) a.in[i] = (const float*)d_in[i];
    a.out = (float*)d_out; a.ws = (unsigned char*)d_ws;
#if MK_PER_PHASE
    for (int k = 0; k < mk::NPH; ++k) { a.ph_lo = k; a.ph_hi = k + 1; hipLaunchKernelGGL(mk::mk_fwd, dim3(256), dim3(512), mk::LDS_BYTES, stream, a); }
#else
    a.ph_lo = 0; a.ph_hi = mk::NPH; hipLaunchKernelGGL(mk::mk_fwd, dim3(256), dim3(512), mk::LDS_BYTES, stream, a);
#endif
}
```

```cpp
#include <hip/hip_runtime.h>
#include <stdint.h>
#include <stdio.h>
#include <math.h>
#define LAS __attribute__((address_space(3)))
#define GAS __attribute__((address_space(1)))
typedef unsigned short bf16_t;
typedef short bf16x8 __attribute__((ext_vector_type(8)));
typedef short s16x4 __attribute__((ext_vector_type(4)));
typedef float f32x2 __attribute__((ext_vector_type(2)));
typedef float f32x4 __attribute__((ext_vector_type(4)));
typedef float f32x16 __attribute__((ext_vector_type(16)));
typedef unsigned u32x2 __attribute__((ext_vector_type(2)));
typedef unsigned u32x4 __attribute__((ext_vector_type(4)));
typedef __bf16 bf16x2_t __attribute__((ext_vector_type(2)));
typedef int v8i32 __attribute__((ext_vector_type(8)));
__device__ __forceinline__ unsigned pk4_fp8(float a, float b, float cc, float d) { int p = __builtin_amdgcn_cvt_pk_fp8_f32(a, b, 0, false); p = __builtin_amdgcn_cvt_pk_fp8_f32(cc, d, p, true); return (unsigned)p; }

__device__ __forceinline__ unsigned pk2(float lo, float hi) { f32x2 v = {lo, hi}; bf16x2_t b = __builtin_convertvector(v, bf16x2_t); return __builtin_bit_cast(unsigned, b); }
__device__ __forceinline__ float bflo(unsigned w) { return __uint_as_float(w << 16); }
__device__ __forceinline__ float bfhi(unsigned w) { return __uint_as_float(w & 0xffff0000u); }
__device__ __forceinline__ float fexp2(float x) { return __builtin_amdgcn_exp2f(x); }
__device__ __forceinline__ float frcp(float x) { return __builtin_amdgcn_rcpf(x); }
__device__ __forceinline__ float fsilu(float x) { return x * frcp(1.f + fexp2(-1.4426950408889634f * x)); }
__device__ __forceinline__ float wsum(float v) {
#pragma unroll
    for (int o = 32; o >= 1; o >>= 1) v += __shfl_xor(v, o);
    return v;
}
__device__ __forceinline__ float xhalf(float v) { return __shfl_xor(v, 32); }
__device__ __forceinline__ int crow(int r, int hi) { return (r & 3) + 8 * (r >> 2) + 4 * hi; }
typedef short v4i16_t __attribute__((ext_vector_type(4)));
__device__ __forceinline__ s16x4 ldtr(LAS const unsigned char* p) { return __builtin_bit_cast(s16x4, __builtin_amdgcn_ds_read_tr16_b64_v4i16((LAS v4i16_t*)p)); }
#define MFMA32(a, b, c) __builtin_amdgcn_mfma_f32_32x32x16_bf16((a), (b), (c), 0, 0, 0)

#define XB_TMO      128
#define XB_XCNT(j)  (256  + 64 * (j))
#define XB_XSUB(j)  (1280 + 64 * (j))
#define XB_XGEN(j)  (2304 + 64 * (j))
#define XB_TOP      3328
#define XB_TOPGEN   3392
#define XCD_BAR_WORDS 3456
#define XB_SPIN_CAP (1u << 18)
__device__ __forceinline__ unsigned xb_ld(unsigned* p)              { return __hip_atomic_load(p, __ATOMIC_RELAXED, __HIP_MEMORY_SCOPE_AGENT); }
__device__ __forceinline__ unsigned xb_add(unsigned* p, unsigned v) { return __hip_atomic_fetch_add(p, v, __ATOMIC_RELAXED, __HIP_MEMORY_SCOPE_AGENT); }
__device__ __forceinline__ unsigned xb_xcc_id() { return (unsigned)__builtin_amdgcn_s_getreg((3 << 11) | 20) & 0xFu; }
#define XB_SPIN(cond, bar) do { unsigned _sp = 0; while (cond) { __builtin_amdgcn_s_sleep(1); \
    if ((++_sp & 255u) == 0u) { if (xb_ld(&(bar)[XB_TMO])) break; if (_sp > XB_SPIN_CAP) { atomicAdd(&(bar)[XB_TMO], 1u); break; } } } } while (0)
struct XcdBarrier { unsigned* bar; unsigned x; volatile LAS unsigned* st; };
__device__ __forceinline__ XcdBarrier xcd_barrier_post(unsigned* bar, volatile LAS unsigned* st) {
    XcdBarrier b; b.bar = bar; b.x = xb_xcc_id(); b.st = st;
    if (threadIdx.x == 0) (void)xb_add(&bar[XB_XCNT(b.x)], 1u);
    return b;
}
__device__ __forceinline__ void xcd_barrier_complete(unsigned* bar, unsigned x, unsigned& nloc, unsigned& nx) {
    const unsigned G = gridDim.x * gridDim.y * gridDim.z;
    unsigned sum, cnt, mine, sp = 0u;
    for (;;) {
        sum = 0u; cnt = 0u; mine = 0u;
#pragma unroll
        for (unsigned j = 0; j < 16; ++j) { const unsigned c = xb_ld(&bar[XB_XCNT(j)]); sum += c; cnt += (c > 0u) ? 1u : 0u; mine = (j == x) ? c : mine; }
        if (sum == G) break;
        __builtin_amdgcn_s_sleep(1);
        if ((++sp & 255u) == 0u) { if (xb_ld(&bar[XB_TMO])) break; if (sp > XB_SPIN_CAP) { atomicAdd(&bar[XB_TMO], 1u); break; } }
    }
    nloc = mine > 0u ? mine : 1u; nx = cnt > 0u ? cnt : 1u;
}
__device__ __forceinline__ void xcd_barrier(const XcdBarrier& b) {
    asm volatile("s_waitcnt vmcnt(0)" ::: "memory");
    __syncthreads();
    if (threadIdx.x == 0) {
        unsigned* bar = b.bar;
        __builtin_amdgcn_s_waitcnt(0);
        unsigned nloc = b.st[0], nx = b.st[1];
        if (nloc == 0u) { xcd_barrier_complete(bar, b.x, nloc, nx); b.st[0] = nloc; b.st[1] = nx; }
        const unsigned old = xb_add(&bar[XB_XSUB(b.x)], 1u);
        const unsigned gen = old / nloc;
        if (old + 1u == (gen + 1u) * nloc) {
            __builtin_amdgcn_fence(__ATOMIC_RELEASE, "agent");
            asm volatile("s_waitcnt vmcnt(0)" ::: "memory");
            const unsigned og = xb_add(&bar[XB_TOP], 1u);
            const unsigned tg = og / nx;
            if (og + 1u == (tg + 1u) * nx) xb_add(&bar[XB_TOPGEN], 1u);
            else XB_SPIN(xb_ld(&bar[XB_TOPGEN]) == tg, bar);
            __builtin_amdgcn_fence(__ATOMIC_ACQUIRE, "agent");
            xb_add(&bar[XB_XGEN(b.x)], 1u);
            asm volatile("s_waitcnt vmcnt(0)" ::: "memory");
        } else {
            XB_SPIN(xb_ld(&bar[XB_XGEN(b.x)]) == gen, bar);
            __builtin_amdgcn_fence(__ATOMIC_ACQUIRE, "agent");
            asm volatile("s_waitcnt vmcnt(0)" ::: "memory");
        }
    }
    __syncthreads();
}

namespace pg8 {
constexpr int BM = 256, BK = 64, HALF = 128, HTB = HALF * BK * 2, STAGE_BYTES = 8 * HTB, NXCD = 8, WGM = 8;
__device__ __forceinline__ int lds_byte(int r, int c) { const int st = (r >> 4) * 2 + (c >> 5), rr = r & 15, cc = c & 31, ob = rr * 64 + cc * 2; return st * 1024 + (ob ^ (((ob >> 9) & 1) << 5)); }
__device__ __forceinline__ void stage_rc(int b, int& R, int& C) { const int st = b / 1024, sb = b % 1024, swz = sb ^ (((sb >> 9) & 1) << 5); R = (st >> 1) * 16 + swz / 64; C = (st & 1) * 32 + (swz % 64) / 2; }
__device__ __forceinline__ int perm32(int rho) { const int n = rho >> 4, i = rho & 15; return 8 * (i >> 2) + 4 * n + (i & 3); }

struct Unit { int pm, pn, pc; unsigned kofs; int nt; };
struct Gemm { const bf16_t* A; const bf16_t* Bt; int K; int lda; LAS const unsigned* rowtab; int ldb; };

struct StaticOrder {
    int nM, nN, nwg, G, c;
    __device__ __forceinline__ void init(int nM_, int nN_, int G_, int c_) { nM = nM_; nN = nN_; nwg = nM * nN; G = G_; c = c_; }
    __device__ __forceinline__ bool map(int i, int& pm, int& pn) const {
        const long L = (long)i * G + c; if (L >= nwg) return false;
        int wgid = (int)L; { const int q = nwg / NXCD, r = nwg % NXCD, xcd = wgid % NXCD, off = wgid / NXCD; wgid = (xcd < r ? xcd * (q + 1) : r * (q + 1) + (xcd - r) * q) + off; }
        const int nig = WGM * nN, gid = wgid / nig, fm = gid * WGM, gsz = (nM - fm) < WGM ? (nM - fm) : WGM;
        pm = fm + ((wgid % nig) % gsz); pn = (wgid % nig) / gsz; return true;
    }
    __device__ __forceinline__ bool next(int i, Unit& u) const { int pm, pn; if (!map(i, pm, pn)) return false; u.pm = pm; u.pn = pn; u.pc = pn; u.kofs = 0u; return true; }
};
struct MoeOrder {
    StaticOrder so; const int* tile_e;
    __device__ __forceinline__ bool next(int i, Unit& u) const { int pm, pn; if (!so.map(i, pm, pn)) return false; u.pm = pm; u.pc = pn; u.pn = tile_e[pm] * so.nN + pn; u.kofs = 0u; return true; }
};

struct MoeDownOrder {
    int F, G, c; const int* tile_e;
    __device__ __forceinline__ bool next(int i, Unit& u) const { const int L = i * G + c; if (L >= F) return false; u.pm = L >> 2; u.pc = L & 3; u.pn = tile_e[u.pm] * 4 + u.pc; u.kofs = 0u; return true; }
};
struct MoeSplitOrder {
    int F, R, S, Ks, c; const int* tile_e;
    __device__ __forceinline__ bool next(int i, Unit& u) const { if (i > 0 || c >= R * S) return false; const int q = c / S, s = c % S; u.pm = (F >> 2) + (q >> 2); const int pc = q & 3;
        u.pn = tile_e[u.pm] * 4 + pc; u.pc = c; u.kofs = (unsigned)(s * Ks * 2); return true; }
};
struct MoeDownAll {
    StaticOrder so; const int* tile_e; int F, R, S, Ks, c, nw, ntw, nts;
    __device__ __forceinline__ bool next(int i, Unit& u) const { int pm, pn;
        if (so.map(i, pm, pn)) { u.pm = pm; u.pc = pn; u.pn = tile_e[pm] * 4 + pn; u.kofs = 0u; u.nt = ntw; return true; }
        if (R == 0 || i != nw || c >= R * S) return false;
        const int q = c / S, s = c % S; u.pm = (F >> 2) + (q >> 2); const int pc = q & 3;
        u.pn = tile_e[u.pm] * 4 + pc; u.pc = 0x10000 | c; u.kofs = (unsigned)(s * Ks * 2); u.nt = nts; return true; }
};
template <class Epi, class Sched, bool ALIGN_EPI, bool FP8 = false, bool VARK = false>
__device__ __forceinline__ void gemm_phase(LAS unsigned char* lds, const Gemm g, const Sched& S, const Epi& E) {
    const int tid = threadIdx.x, wid = __builtin_amdgcn_readfirstlane(tid >> 6), lane = tid & 63, wr = wid >> 2, wc = wid & 3, fr = lane & 15, fq = lane >> 4;
    const int K = g.K, nt = K / BK;
    int Ra[2]; unsigned Ca[2], voffB[2];
#pragma unroll
    for (int i = 0; i < 2; ++i) { int R, C; stage_rc(tid * 16 + i * 8192, R, C); const int Rb = Epi::PERM ? ((R & ~31) + perm32(R & 31)) : R;
        Ra[i] = R; Ca[i] = (unsigned)C * 2u; voffB[i] = (unsigned)(Rb * g.ldb + C) * 2u; }
    const unsigned kstep = (unsigned)(BK * 2);
    const size_t hstep = (size_t)HALF * g.ldb * 2;
    const size_t tstep = 2 * hstep;
    const unsigned rowb = (unsigned)g.lda * 2u;
    const unsigned ldsw = (unsigned)wid * 1024u;
    const int aoff = lds_byte(wr * 64 + fr, fq * 8), boff = lds_byte(wc * 32 + fr, fq * 8);
#define PG8_SA(b, h) (((b) * 2 + (h)) * HTB)
#define PG8_SB(b, h) ((4 + (b) * 2 + (h)) * HTB)
#define PG8_STAGE(bufoff, gbase, voff) do { _Pragma("unroll") for (int _i = 0; _i < 2; ++_i) \
        __builtin_amdgcn_global_load_lds((const unsigned*)((const char*)(gbase) + (voff)[_i]), (LAS unsigned*)(lds + (bufoff) + ldsw + _i * 8192), 16, 0, 0); } while (0)
#define PG8_STAGEA(bufoff, offs, kb) do { _Pragma("unroll") for (int _i = 0; _i < 2; ++_i) \
        __builtin_amdgcn_global_load_lds((const unsigned*)((const char*)g.A + (size_t)((offs)[_i] + (kb))), (LAS unsigned*)(lds + (bufoff) + ldsw + _i * 8192), 16, 0, 0); } while (0)
#define PG8_AOFF(dst, u, ui_) do { _Pragma("unroll") for (int _h = 0; _h < 2; ++_h) _Pragma("unroll") for (int _i = 0; _i < 2; ++_i) { \
        const int _rl = _h * 128 + Ra[_i]; \
        dst[_h][_i] = (g.rowtab ? g.rowtab[(ui_) * 256 + _rl] : (unsigned)((u).pm * 256 + _rl) * rowb) + Ca[_i] + (u).kofs; } } while (0)
#define PG8_LDA(dst, b, h) do { _Pragma("unroll") for (int m = 0; m < 4; ++m) _Pragma("unroll") for (int k = 0; k < 2; ++k) dst[m][k] = *(const LAS bf16x8*)(lds + PG8_SA(b, h) + aoff + m * 2048 + k * 1024); } while (0)
#define PG8_LDB(dst, b, h) do { _Pragma("unroll") for (int n = 0; n < 2; ++n) _Pragma("unroll") for (int k = 0; k < 2; ++k) dst[n][k] = *(const LAS bf16x8*)(lds + PG8_SB(b, h) + boff + n * 2048 + k * 1024); } while (0)
#define PG8_CAT8(x0, x1) __builtin_shufflevector(__builtin_bit_cast(u32x4, x0), __builtin_bit_cast(u32x4, x1), 0, 1, 2, 3, 4, 5, 6, 7)
#define PG8_MMA(ai, bj, At, Bt) do { __builtin_amdgcn_s_setprio(1); _Pragma("unroll") for (int m = 0; m < 4; ++m) _Pragma("unroll") for (int n = 0; n < 2; ++n) { \
        if constexpr (FP8) { acc[ai][bj][m][n] = __builtin_amdgcn_mfma_scale_f32_16x16x128_f8f6f4(__builtin_bit_cast(v8i32, PG8_CAT8(Bt[n][0], Bt[n][1])), __builtin_bit_cast(v8i32, PG8_CAT8(At[m][0], At[m][1])), acc[ai][bj][m][n], 0, 0, 0, 0, 0, 0); } \
        else { _Pragma("unroll") for (int k = 0; k < 2; ++k) acc[ai][bj][m][n] = __builtin_amdgcn_mfma_f32_16x16x32_bf16(Bt[n][k], At[m][k], acc[ai][bj][m][n], 0, 0, 0); } } __builtin_amdgcn_s_setprio(0); } while (0)
#define PG8_WAIT_V(n) asm volatile("s_waitcnt vmcnt(" #n ")" ::: "memory")
#define PG8_WAIT_L(n) asm volatile("s_waitcnt lgkmcnt(" #n ")" ::: "memory")
#define PG8_BAR __builtin_amdgcn_s_barrier()
#define PG8_SCHED __builtin_amdgcn_sched_barrier(0)
    Unit cur, nxt; int ui = 0;
    if (!S.next(0, cur)) return;
    f32x4 acc[2][2][4][2];
#pragma unroll
    for (int a = 0; a < 2; ++a)
#pragma unroll
        for (int b = 0; b < 2; ++b)
#pragma unroll
            for (int m = 0; m < 4; ++m)
#pragma unroll
                for (int n = 0; n < 2; ++n) acc[a][b][m][n] = (f32x4){0.f, 0.f, 0.f, 0.f};
    bf16x8 At[4][2], B0[2][2], B1[2][2];
    unsigned coff[2][2], noff[2][2];
    PG8_AOFF(coff, cur, 0);
    const char* cB = (const char*)g.Bt + (size_t)cur.pn * tstep + cur.kofs;
    PG8_STAGE(PG8_SB(0, 0), cB, voffB); PG8_STAGE(PG8_SB(0, 1), cB + hstep, voffB); PG8_STAGEA(PG8_SA(0, 0), coff[0], 0u); PG8_STAGEA(PG8_SA(0, 1), coff[1], 0u);
    if (wr == 1) PG8_BAR;
    PG8_WAIT_V(2); PG8_BAR;
    PG8_STAGE(PG8_SB(1, 0), cB + kstep, voffB); PG8_STAGEA(PG8_SA(1, 0), coff[0], kstep); PG8_STAGE(PG8_SB(1, 1), cB + hstep + kstep, voffB);
    PG8_WAIT_V(6); PG8_BAR;
    for (;;) {
        const bool has_next = S.next(ui + 1, nxt);
        if constexpr (FP8) { }
        else if (has_next) { PG8_AOFF(noff, nxt, ui + 1); }
        else {
#pragma unroll
            for (int h = 0; h < 2; ++h)
#pragma unroll
                for (int i = 0; i < 2; ++i) noff[h][i] = coff[h][i]; }
        const char* nB = has_next ? (const char*)g.Bt + (size_t)nxt.pn * tstep + nxt.kofs : cB;
        const int ntc = VARK ? cur.nt : nt;
        for (int t = 0; t < ntc; t += 2) {
            const bool last = (t == ntc - 2);
            const unsigned k1 = (unsigned)(t + 1) * kstep, k2 = (unsigned)(t + 2) * kstep;
            unsigned o2[2][2]; const unsigned kx = last ? 0u : k2;
            if constexpr (!FP8) {
#pragma unroll
                for (int h = 0; h < 2; ++h)
#pragma unroll
                    for (int i = 0; i < 2; ++i) o2[h][i] = last ? noff[h][i] : coff[h][i] + k2; }
#define PG8_STAGEA2(bufoff, h, kadd) do { if constexpr (FP8) { PG8_STAGEA(bufoff, coff[h], kx + (kadd)); } else { PG8_STAGEA(bufoff, o2[h], (kadd)); } } while (0)
            const char* b2 = last ? nB : cB + (size_t)k2;
            const char* b3 = b2 + kstep;
            PG8_LDB(B0, 0, 0); PG8_LDB(B1, 0, 1); PG8_SCHED; PG8_LDA(At, 0, 0); PG8_STAGEA(PG8_SA(1, 1), coff[1], k1);
            if constexpr (FP8) { if (last && has_next) { PG8_AOFF(coff, nxt, ui + 1); } }
            PG8_WAIT_V(8); PG8_WAIT_L(0); PG8_BAR; PG8_MMA(0, 0, At, B0); PG8_MMA(0, 1, At, B1); PG8_BAR; PG8_SCHED;
            PG8_LDA(At, 0, 1); PG8_STAGE(PG8_SB(0, 0), b2, voffB); PG8_STAGE(PG8_SB(0, 1), b2 + hstep, voffB); PG8_STAGEA2(PG8_SA(0, 0), 0, 0u);
            PG8_WAIT_V(8); PG8_WAIT_L(0); PG8_BAR; PG8_MMA(1, 0, At, B0); PG8_MMA(1, 1, At, B1); PG8_BAR; PG8_SCHED;
            PG8_LDB(B0, 1, 0); PG8_LDB(B1, 1, 1); PG8_SCHED; PG8_LDA(At, 1, 0); PG8_STAGEA2(PG8_SA(0, 1), 1, 0u);
            PG8_WAIT_V(8); PG8_WAIT_L(0); PG8_BAR; PG8_MMA(0, 0, At, B0); PG8_MMA(0, 1, At, B1); PG8_BAR; PG8_SCHED;
            PG8_LDA(At, 1, 1); PG8_STAGE(PG8_SB(1, 0), b3, voffB); PG8_STAGE(PG8_SB(1, 1), b3 + hstep, voffB); PG8_STAGEA2(PG8_SA(1, 0), 0, kstep);
            PG8_WAIT_V(8); PG8_WAIT_L(0); PG8_BAR; PG8_MMA(1, 0, At, B0); PG8_MMA(1, 1, At, B1); PG8_BAR; PG8_SCHED;
        }
        if constexpr (ALIGN_EPI) { if (wr == 0) PG8_BAR; }
        { int fr2 = fr, fq2 = fq; asm volatile("" : "+v"(fr2), "+v"(fq2));
          E(acc, cur, wr, wc, fr2, fq2); }
        if (!has_next) break;
#pragma unroll
        for (int a = 0; a < 2; ++a)
#pragma unroll
            for (int b = 0; b < 2; ++b)
#pragma unroll
                for (int m = 0; m < 4; ++m)
#pragma unroll
                    for (int n = 0; n < 2; ++n) acc[a][b][m][n] = (f32x4){0.f, 0.f, 0.f, 0.f};
        cur = nxt; cB = nB; ++ui;
        if constexpr (!FP8) {
#pragma unroll
            for (int h = 0; h < 2; ++h)
#pragma unroll
                for (int i = 0; i < 2; ++i) coff[h][i] = noff[h][i]; }
        if constexpr (ALIGN_EPI) { if (wr == 1) PG8_BAR; }
    }
    PG8_WAIT_V(0);
    if constexpr (!ALIGN_EPI) { if (wr == 0) PG8_BAR; }
    PG8_BAR;
#undef PG8_SA
#undef PG8_SB
#undef PG8_STAGE
#undef PG8_STAGEA
#undef PG8_STAGEA2
#undef PG8_AOFF
#undef PG8_LDA
#undef PG8_LDB
#undef PG8_MMA
#undef PG8_CAT8
#undef PG8_WAIT_V
#undef PG8_WAIT_L
#undef PG8_BAR
#undef PG8_SCHED
}

__device__ __forceinline__ void xpose4(unsigned (&r)[4], int fq) {
    { auto t = __builtin_amdgcn_permlane32_swap(r[0], r[2], false, false); r[0] = t[0]; r[2] = t[1]; }
    { auto t = __builtin_amdgcn_permlane32_swap(r[1], r[3], false, false); r[1] = t[0]; r[3] = t[1]; }
    const bool odd = fq & 1;
    { const unsigned rcv = (unsigned)__shfl_xor((int)(odd ? r[0] : r[1]), 16); if (odd) r[0] = rcv; else r[1] = rcv; }
    { const unsigned rcv = (unsigned)__shfl_xor((int)(odd ? r[2] : r[3]), 16); if (odd) r[2] = rcv; else r[3] = rcv; }
}
struct EpiStore {
    static constexpr bool PERM = true;
    bf16_t* O; int ldc;
    __device__ __forceinline__ void operator()(const f32x4 (&acc)[2][2][4][2], const Unit& u, int wr, int wc, int fr, int fq) const {
        const int row0 = u.pm * BM + wr * 64 + fr; const int col0 = u.pc * BM + wc * 32 + 8 * fq;
#pragma unroll
        for (int ai = 0; ai < 2; ++ai)
#pragma unroll
            for (int m = 0; m < 4; ++m) { bf16_t* rowp = O + (size_t)(row0 + ai * HALF + m * 16) * ldc + col0;
#pragma unroll
                for (int bj = 0; bj < 2; ++bj) { const f32x4 v0 = acc[ai][bj][m][0], v1 = acc[ai][bj][m][1];
                    u32x4 w; w.x = pk2(v0[0], v0[1]); w.y = pk2(v0[2], v0[3]); w.z = pk2(v1[0], v1[1]); w.w = pk2(v1[2], v1[3]);
                    *(u32x4*)(rowp + bj * HALF) = w; } }
    }
};
struct EpiPartial {
    static constexpr bool PERM = false;
    float* P;
    __device__ __forceinline__ void operator()(const f32x4 (&acc)[2][2][4][2], const Unit& u, int wr, int wc, int fr, int fq) const {
        float* base = P + (size_t)u.pc * 65536 + (size_t)(wr * 64 + fr) * 256 + wc * 32 + 4 * fq;
#pragma unroll
        for (int ai = 0; ai < 2; ++ai)
#pragma unroll
            for (int m = 0; m < 4; ++m) { float* rp = base + (size_t)(ai * HALF + m * 16) * 256; asm volatile("" : "+v"(rp));
#pragma unroll
                for (int bj = 0; bj < 2; ++bj)
#pragma unroll
                    for (int n = 0; n < 2; ++n) *(f32x4*)(rp + bj * HALF + n * 16) = acc[ai][bj][m][n]; }
    }
};
struct EpiSwiglu {
    static constexpr bool PERM = true;
    bf16_t* O; int ldc; float pre;
    __device__ __forceinline__ void operator()(const f32x4 (&acc)[2][2][4][2], const Unit& u, int wr, int wc, int fr, int fq) const {
        const int row0 = u.pm * BM + wr * 64 + fq * 16 + fr; const int col0 = u.pc * 128 + wc * 16;
#pragma unroll
        for (int ai = 0; ai < 2; ++ai)
#pragma unroll
            for (int bj = 0; bj < 2; ++bj) { unsigned lo[4], hi[4];
#pragma unroll
                for (int m = 0; m < 4; ++m) { const f32x4 v0 = acc[ai][bj][m][0] * pre, v1 = acc[ai][bj][m][1] * pre;
                    const float h0 = fsilu(v0[0]) * v0[1], h1 = fsilu(v0[2]) * v0[3], h2 = fsilu(v1[0]) * v1[1], h3 = fsilu(v1[2]) * v1[3];
                    lo[m] = pk2(h0, h1); hi[m] = pk2(h2, h3); }
                xpose4(lo, fq); xpose4(hi, fq);
                bf16_t* rowp = O + (size_t)(row0 + ai * HALF) * ldc + col0 + bj * 64;
                u32x4 w0; w0.x = lo[0]; w0.y = hi[0]; w0.z = lo[1]; w0.w = hi[1];
                u32x4 w1; w1.x = lo[2]; w1.y = hi[2]; w1.z = lo[3]; w1.w = hi[3];
                *(u32x4*)rowp = w0; *(u32x4*)(rowp + 8) = w1; }
    }
};
struct EpiSwigluQ8 {
    static constexpr bool PERM = true;
    unsigned char* O; int ldc; float pre;
    __device__ __forceinline__ void operator()(const f32x4 (&acc)[2][2][4][2], const Unit& u, int wr, int wc, int fr, int fq) const {
        const int row0 = u.pm * BM + wr * 64 + fq * 16 + fr; const int col0 = u.pc * 128 + wc * 16;
#pragma unroll
        for (int ai = 0; ai < 2; ++ai)
#pragma unroll
            for (int bj = 0; bj < 2; ++bj) { unsigned r[4];
#pragma unroll
                for (int m = 0; m < 4; ++m) { const f32x4 v0 = acc[ai][bj][m][0] * pre, v1 = acc[ai][bj][m][1] * pre;
                    const float h0 = fsilu(v0[0]) * v0[1], h1 = fsilu(v0[2]) * v0[3], h2 = fsilu(v1[0]) * v1[1], h3 = fsilu(v1[2]) * v1[3];
                    r[m] = pk4_fp8(h0, h1, h2, h3); }
                xpose4(r, fq);
                u32x4 w; w.x = r[0]; w.y = r[1]; w.z = r[2]; w.w = r[3];
                *(u32x4*)(O + (size_t)(row0 + ai * HALF) * ldc + col0 + bj * 64) = w; }
    }
};
struct EpiStoreS {
    static constexpr bool PERM = true;
    bf16_t* O; int ldc; float pre;
    __device__ __forceinline__ void operator()(const f32x4 (&acc)[2][2][4][2], const Unit& u, int wr, int wc, int fr, int fq) const {
        const int row0 = u.pm * BM + wr * 64 + fr; const int col0 = u.pc * BM + wc * 32 + 8 * fq;
#pragma unroll
        for (int ai = 0; ai < 2; ++ai)
#pragma unroll
            for (int m = 0; m < 4; ++m) { bf16_t* rowp = O + (size_t)(row0 + ai * HALF + m * 16) * ldc + col0;
#pragma unroll
                for (int bj = 0; bj < 2; ++bj) { const f32x4 v0 = acc[ai][bj][m][0] * pre, v1 = acc[ai][bj][m][1] * pre;
                    u32x4 w; w.x = pk2(v0[0], v0[1]); w.y = pk2(v0[2], v0[3]); w.z = pk2(v1[0], v1[1]); w.w = pk2(v1[2], v1[3]);
                    *(u32x4*)(rowp + bj * HALF) = w; } }
    }
};
struct EpiPartialS {
    static constexpr bool PERM = false;
    float* P; float pre;
    __device__ __forceinline__ void operator()(const f32x4 (&acc)[2][2][4][2], const Unit& u, int wr, int wc, int fr, int fq) const {
        float* base = P + (size_t)u.pc * 65536 + (size_t)(wr * 64 + fr) * 256 + wc * 32 + 4 * fq;
#pragma unroll
        for (int ai = 0; ai < 2; ++ai)
#pragma unroll
            for (int m = 0; m < 4; ++m)
#pragma unroll
                for (int bj = 0; bj < 2; ++bj)
#pragma unroll
                    for (int n = 0; n < 2; ++n) *(f32x4*)(base + (size_t)(ai * HALF + m * 16) * 256 + bj * HALF + n * 16) = acc[ai][bj][m][n] * pre;
    }
};
struct EpiDownAll {
    static constexpr bool PERM = true;
    bf16_t* O; int ldc; float pre; float* P;
    __device__ __forceinline__ void operator()(const f32x4 (&acc)[2][2][4][2], const Unit& u, int wr, int wc, int fr, int fq) const {
        if (u.pc < 0x10000) {
            const int row0 = u.pm * BM + wr * 64 + fr; const int col0 = u.pc * BM + wc * 32 + 8 * fq;
#pragma unroll
            for (int ai = 0; ai < 2; ++ai)
#pragma unroll
                for (int m = 0; m < 4; ++m) { bf16_t* rowp = O + (size_t)(row0 + ai * HALF + m * 16) * ldc + col0;
#pragma unroll
                    for (int bj = 0; bj < 2; ++bj) { const f32x4 v0 = acc[ai][bj][m][0] * pre, v1 = acc[ai][bj][m][1] * pre;
                        u32x4 w; w.x = pk2(v0[0], v0[1]); w.y = pk2(v0[2], v0[3]); w.z = pk2(v1[0], v1[1]); w.w = pk2(v1[2], v1[3]);
                        *(u32x4*)(rowp + bj * HALF) = w; } }
        } else {
            float* base = P + (size_t)(u.pc & 0xffff) * 65536 + (size_t)(wr * 64 + fr) * 256 + wc * 32 + 8 * fq;
#pragma unroll
            for (int ai = 0; ai < 2; ++ai)
#pragma unroll
                for (int m = 0; m < 4; ++m) { float* rp = base + (size_t)(ai * HALF + m * 16) * 256; asm volatile("" : "+v"(rp));
#pragma unroll
                    for (int bj = 0; bj < 2; ++bj)
#pragma unroll
                        for (int n = 0; n < 2; ++n) *(f32x4*)(rp + bj * HALF + n * 4) = acc[ai][bj][m][n]; }
        }
    }
};
struct EpiResidB {
    static constexpr bool PERM = true;
    const float* xin_f; const bf16_t* xin_b; bf16_t* xout; const float* gate; float pre;
    __device__ __forceinline__ void operator()(const f32x4 (&acc)[2][2][4][2], const Unit& u, int wr, int wc, int fr, int fq) const {
        const int row0 = u.pm * BM + wr * 64 + fr; const int col0 = u.pc * BM + wc * 32 + 8 * fq;
        f32x4 gv[2][2];
#pragma unroll
        for (int bj = 0; bj < 2; ++bj)
#pragma unroll
            for (int n = 0; n < 2; ++n) gv[bj][n] = *(const f32x4*)(gate + col0 + bj * HALF + n * 4) * pre;
#pragma unroll
        for (int ai = 0; ai < 2; ++ai)
#pragma unroll
            for (int mh = 0; mh < 2; ++mh) { f32x4 xa[2][2][2];
                if (xin_f) {
#pragma unroll
                    for (int mm = 0; mm < 2; ++mm)
#pragma unroll
                        for (int bj = 0; bj < 2; ++bj) { const float* p = xin_f + (size_t)(row0 + ai * HALF + (2 * mh + mm) * 16) * 1024 + col0 + bj * HALF; xa[mm][bj][0] = *(const f32x4*)p; xa[mm][bj][1] = *(const f32x4*)(p + 4); }
                } else { u32x4 wv[2][2];
#pragma unroll
                    for (int mm = 0; mm < 2; ++mm)
#pragma unroll
                        for (int bj = 0; bj < 2; ++bj) wv[mm][bj] = *(const u32x4*)(xin_b + (size_t)(row0 + ai * HALF + (2 * mh + mm) * 16) * 1024 + col0 + bj * HALF);
#pragma unroll
                    for (int mm = 0; mm < 2; ++mm)
#pragma unroll
                        for (int bj = 0; bj < 2; ++bj) { const u32x4 w = wv[mm][bj]; xa[mm][bj][0] = (f32x4){bflo(w.x), bfhi(w.x), bflo(w.y), bfhi(w.y)}; xa[mm][bj][1] = (f32x4){bflo(w.z), bfhi(w.z), bflo(w.w), bfhi(w.w)}; } }
                asm volatile("" ::: "memory");
#pragma unroll
                for (int mm = 0; mm < 2; ++mm)
#pragma unroll
                    for (int bj = 0; bj < 2; ++bj) { const int m = 2 * mh + mm; const f32x4 x0 = xa[mm][bj][0] + gv[bj][0] * acc[ai][bj][m][0], x1 = xa[mm][bj][1] + gv[bj][1] * acc[ai][bj][m][1];
                        u32x4 o; o.x = pk2(x0[0], x0[1]); o.y = pk2(x0[2], x0[3]); o.z = pk2(x1[0], x1[1]); o.w = pk2(x1[2], x1[3]);
                        *(u32x4*)(xout + (size_t)(row0 + ai * HALF + m * 16) * 1024 + col0 + bj * HALF) = o; } }
    }
};
struct EpiResid {
    static constexpr bool PERM = false;
    const float* xin_lat; const float* xin_ctx; float* xout_lat; float* xout_ctx; const float* gate_lat; const float* gate_ctx;
    __device__ __forceinline__ void operator()(const f32x4 (&acc)[2][2][4][2], const Unit& u, int wr, int wc, int fr, int fq) const {
        const bool isctx = u.pm >= 64; const int rbase = (isctx ? (u.pm - 64) : u.pm) * BM + wr * 64 + fr;
        const float* xin = isctx ? xin_ctx : xin_lat; float* xout = isctx ? xout_ctx : xout_lat; const float* gate = isctx ? gate_ctx : gate_lat;
        const int col0 = u.pc * BM + wc * 32 + 4 * fq;
        f32x4 gv[2][2];
#pragma unroll
        for (int bj = 0; bj < 2; ++bj)
#pragma unroll
            for (int n = 0; n < 2; ++n) gv[bj][n] = *(const f32x4*)(gate + col0 + bj * HALF + n * 16);
#pragma unroll
        for (int ai = 0; ai < 2; ++ai)
#pragma unroll
            for (int m = 0; m < 4; ++m) { const size_t off = (size_t)(rbase + ai * HALF + m * 16) * 1024 + col0;
#pragma unroll
                for (int bj = 0; bj < 2; ++bj)
#pragma unroll
                    for (int n = 0; n < 2; ++n) { const f32x4 xi = *(const f32x4*)(xin + off + bj * HALF + n * 16);
                        *(f32x4*)(xout + off + bj * HALF + n * 16) = xi + gv[bj][n] * acc[ai][bj][m][n]; } }
    }
};
}
namespace mk {
constexpr int SEQ = 16384, CTXL = 256, ROWS = SEQ + CTXL, DM = 1024;
constexpr float EPS = 1e-6f, LOG2E = 1.4426950408889634f;
constexpr int NTHR = 512, NCHUNK = 130, ZROW = SEQ;
constexpr size_t al256(size_t x) { return (x + 255) & ~(size_t)255; }
constexpr size_t WS_BAR = 0;
constexpr size_t WS_MOD = 16384;
constexpr size_t WS_CTXS = WS_MOD + al256(4 * 6144 * 4);
constexpr size_t WS_TOKE = WS_CTXS + (size_t)CTXL * DM * 4;
constexpr size_t WS_TOKW = WS_TOKE + (size_t)SEQ * 2 * 4;
constexpr size_t WS_TOKS = WS_TOKW + (size_t)SEQ * 2 * 4;
constexpr size_t WS_CNTG = WS_TOKS + (size_t)SEQ * 2 * 4;
constexpr size_t WS_ROWT = WS_CNTG + 256 * 8 * 4;
constexpr size_t WS_TILE = WS_ROWT + (size_t)136 * 256 * 4;
constexpr size_t WS_W1IN = WS_TILE + 1024;
constexpr size_t WS_W1UQ = WS_W1IN + (size_t)768 * 1024 * 2;
constexpr size_t WS_W1UKV = WS_W1UQ + (size_t)768 * 384 * 2;
constexpr size_t WS_W1OUT = WS_W1UKV + (size_t)1024 * 256 * 2;
constexpr size_t WS_WE13 = WS_W1OUT + (size_t)1024 * 512 * 2;
constexpr size_t WS_WE2 = WS_WE13 + (size_t)8 * 7168 * 1024 * 2;
constexpr size_t WS_REGA = WS_WE2 + (size_t)8 * 1024 * 3584 * 2;
constexpr size_t WS_W0IN = WS_REGA;
constexpr size_t WS_W0OUT = WS_W0IN + (size_t)2816 * 1024 * 2;
constexpr size_t WS_W013 = WS_W0OUT + (size_t)1024 * 1024 * 2;
constexpr size_t WS_W02 = WS_W013 + (size_t)5632 * 1024 * 2;
constexpr size_t WS_XN = WS_W02 + (size_t)1024 * 2816 * 2;
constexpr size_t WS_XB = WS_WE13 + ((size_t)80 << 20);
constexpr size_t WS_PART = WS_WE13;
constexpr size_t WS_Y = WS_REGA;
constexpr size_t WS_REGB = WS_REGA + (size_t)34816 * 1024 * 2;
constexpr size_t WS_HM = WS_REGB;
constexpr size_t WS_P0 = WS_REGB;
constexpr size_t WS_CAT = WS_P0 + (size_t)ROWS * 2816 * 2;
constexpr size_t WS_KP = WS_CAT + (size_t)ROWS * 1024 * 2;
constexpr size_t WS_RETU = WS_KP + (size_t)ROWS * 128 * 2;
constexpr size_t WS_RETS = WS_RETU + (size_t)16 * NCHUNK * 4096 * 4;
constexpr size_t WS_P1 = WS_REGB;
constexpr size_t WS_Q1 = WS_P1 + (size_t)ROWS * 768 * 2;
constexpr size_t WS_KV1 = WS_Q1 + (size_t)SEQ * 768 * 2;
constexpr size_t WS_K1 = WS_KV1 + (size_t)ROWS * 1024 * 2;
constexpr size_t WS_O1 = WS_K1 + (size_t)ROWS * 768 * 2;
constexpr size_t WS_KR = WS_O1 + (size_t)SEQ * 512 * 2;
constexpr size_t WS_ROPE = WS_REGB + (size_t)34816 * 3584 * 2;
constexpr size_t WS_END = WS_ROPE + 32768;
static_assert(WS_XN + (size_t)(ROWS + 1) * 2048 <= WS_REGB, "region A");
static_assert(WS_RETS + (size_t)16 * NCHUNK * 4096 * 2 <= WS_END && WS_KR + (size_t)ROWS * 64 <= WS_END, "region B");

struct Args { const float* in[34]; float* out; unsigned char* ws; int ph_lo, ph_hi; };
struct Ctx { const Args* a; LAS unsigned char* lds; int tid, lane, wid, b; };
#define WSP(T, off) ((T*)(A.ws + (off)))

__device__ __forceinline__ void ph_ada(const Args& A, const Ctx& c) {
    if (c.b >= 192) return;
    LAS float* sc = (LAS float*)c.lds; LAS float* scc = sc + 1024; LAS float* part = scc + 1024;
    const int L = c.b / 96, cb = (c.b % 96) * 64, cg = c.lane & 15, kq = c.lane >> 4;
    const float* w = L ? A.in[16] : A.in[4]; const float* bias = L ? A.in[17] : A.in[5];
    for (int i = c.tid; i < 1024; i += NTHR) { const float x = A.in[1][i], y = A.in[3][i]; sc[i] = x / (1.f + __expf(-x)); scc[i] = y / (1.f + __expf(-y)); }
    __syncthreads();
    f32x4 a0 = (f32x4){0.f, 0.f, 0.f, 0.f}, a1 = a0; const float* wp = w + (size_t)(c.wid * 128 + kq) * 6144 + cb + 4 * cg;
#pragma unroll
    for (int k = 0; k < 128; k += 4) { const f32x4 wv = *(const f32x4*)(wp + (size_t)k * 6144); const float s0 = sc[c.wid * 128 + k + kq], s1 = scc[c.wid * 128 + k + kq]; a0 = a0 + wv * s0; a1 = a1 + wv * s1; }
#pragma unroll
    for (int i = 0; i < 4; ++i) { a0[i] += __shfl_xor(a0[i], 16); a0[i] += __shfl_xor(a0[i], 32); a1[i] += __shfl_xor(a1[i], 16); a1[i] += __shfl_xor(a1[i], 32); }
    if (kq == 0) { *(LAS f32x4*)(part + (c.wid * 2 + 0) * 64 + 4 * cg) = a0; *(LAS f32x4*)(part + (c.wid * 2 + 1) * 64 + 4 * cg) = a1; }
    __syncthreads();
    if (c.tid < 128) { const int j = c.tid & 63, wh = c.tid >> 6; float s = bias[cb + j];
#pragma unroll
        for (int v = 0; v < 8; ++v) s += part[(v * 2 + wh) * 64 + j];
        WSP(float, WS_MOD)[(L * 2 + wh) * 6144 + cb + j] = s; }
    __syncthreads();
}

constexpr int WS_ADACNT = 4064;
__device__ __forceinline__ void ada_signal(const Args& A, const Ctx& c) {
    asm volatile("s_waitcnt vmcnt(0)" ::: "memory");
    __syncthreads();
    if (c.tid == 0) { __builtin_amdgcn_fence(__ATOMIC_RELEASE, "agent"); xb_add(WSP(unsigned, WS_BAR) + WS_ADACNT, 1u); }
}
__device__ __forceinline__ void ada_wait(const Args& A, const Ctx& c) {
    if (c.tid == 0) { unsigned* cnt = WSP(unsigned, WS_BAR) + WS_ADACNT; while (xb_ld(cnt) < gridDim.x) __builtin_amdgcn_s_sleep(1); __builtin_amdgcn_fence(__ATOMIC_ACQUIRE, "agent"); }
    __syncthreads();
}
struct CvtJob { const float* src; bf16_t* dst; int K, N, tn, rmul, roff, s0, s1, start; };
__device__ __forceinline__ void ph_convert(const Args& A, const Ctx& c) {
    LAS unsigned long long* jp = (LAS unsigned long long*)c.lds;
    LAS int* jm = (LAS int*)(c.lds + 1024);
    LAS int* total_p = (LAS int*)(c.lds + 4096 - 16);
    if (c.tid == 0) {
        int nj = 0, start = 0;
        auto add = [&](const float* src, bf16_t* dst, int K, int N, int Npad, int rmul, int roff, int s0, int s1) {
            jp[nj * 2] = (unsigned long long)(uintptr_t)src; jp[nj * 2 + 1] = (unsigned long long)(uintptr_t)dst;
            jm[nj * 8 + 0] = K; jm[nj * 8 + 1] = N; jm[nj * 8 + 2] = Npad / 256; jm[nj * 8 + 3] = rmul; jm[nj * 8 + 4] = roff; jm[nj * 8 + 5] = s0; jm[nj * 8 + 6] = s1; jm[nj * 8 + 7] = start;
            ++nj; start += (K / 64) * (Npad / 256); };
        for (int e = 0; e < 8; ++e) {
            add(A.in[31] + (size_t)e * 1024 * 3584, (bf16_t*)(WSP(unsigned char, WS_WE13) + (size_t)e * 7168 * 1024), 1024, 3584, 3584, 2, 0, -1, 0);
            add(A.in[32] + (size_t)e * 1024 * 3584, (bf16_t*)(WSP(unsigned char, WS_WE13) + (size_t)e * 7168 * 1024), 1024, 3584, 3584, 2, 1, -1, 0);
            add(A.in[33] + (size_t)e * 3584 * 1024, (bf16_t*)(WSP(unsigned char, WS_WE2) + (size_t)e * 1024 * 3584), 3584, 1024, 1024, 1, 0, -1, 0);
        }
        add(A.in[8], WSP(bf16_t, WS_W0IN), 1024, 2816, 2816, 1, 0, 512, 1024);
        add(A.in[12], WSP(bf16_t, WS_W0OUT), 1024, 1024, 1024, 1, 0, 0, 0);
        add(A.in[13], WSP(bf16_t, WS_W013), 1024, 2816, 2816, 2, 0, 0, 0);
        add(A.in[14], WSP(bf16_t, WS_W013), 1024, 2816, 2816, 2, 1, 0, 0);
        add(A.in[15], WSP(bf16_t, WS_W02), 2816, 1024, 1024, 1, 0, 0, 0);
        add(A.in[20], WSP(bf16_t, WS_W1IN), 1024, 672, 768, 1, 0, 0, 0);
        add(A.in[23], WSP(bf16_t, WS_W1UQ), 384, 768, 768, 1, 0, 0, 0);
        add(A.in[24], WSP(bf16_t, WS_W1UKV), 256, 1024, 1024, 1, 0, 0, 0);
        add(A.in[29], WSP(bf16_t, WS_W1OUT), 512, 1024, 1024, 1, 0, 0, 0);
        *total_p = start;
    }
    __syncthreads();
    const int total = *total_p;
    LAS unsigned char* img = c.lds + 4096;
    struct TM { bf16_t* dst; int K, rmul, roff, k0, n0; bool q8; float sc; };
#define CVT_LOAD(tq_, v_, m_) do { const bool val_ = (tq_) < total; const int t_ = val_ ? (tq_) : 0; int j_ = 0;        \
        _Pragma("unroll 1") for (int q_ = 1; q_ < 33; ++q_) if (jm[q_ * 8 + 7] <= t_) j_ = q_; \
        const float* src_ = (const float*)(uintptr_t)jp[j_ * 2]; const int N_ = jm[j_ * 8 + 1], tn_ = jm[j_ * 8 + 2], s0_ = jm[j_ * 8 + 5], s1_ = jm[j_ * 8 + 6]; \
        const int lt_ = t_ - jm[j_ * 8 + 7], lp_ = lt_ >> 1, tk_ = 2 * (lp_ / tn_) + (lt_ & 1), tq2_ = lp_ % tn_;        \
        m_.dst = (bf16_t*)(uintptr_t)jp[j_ * 2 + 1]; m_.K = jm[j_ * 8]; m_.rmul = jm[j_ * 8 + 3]; m_.roff = jm[j_ * 8 + 4]; m_.k0 = tk_ * 64; m_.n0 = tq2_ * 256; \
        const int nn_ = m_.n0 + 4 * c.lane; const bool ok_ = nn_ < N_; m_.q8 = s0_ < 0; m_.sc = !ok_ ? 0.f : (m_.q8 ? 64.f : ((nn_ >= s0_ && nn_ < s1_) ? 0.125f : 1.f)); \
        const float* sp_ = src_ + (val_ ? (size_t)m_.k0 * N_ + (ok_ ? nn_ : 0) : (size_t)0); const size_t rs_ = val_ ? (size_t)N_ : (size_t)0; \
        _Pragma("unroll") for (int q_ = 0; q_ < 8; ++q_) { const int kr_ = m_.q8 ? 2 * (c.wid + 8 * (q_ >> 1)) + (q_ & 1) : c.wid + 8 * q_; \
            v_[q_] = *(const GAS f32x4*)(uintptr_t)(sp_ + (size_t)kr_ * rs_); } } while (0)
    f32x4 va[8], vb[8], vd[8]; TM ma, mb, md; ma.dst = nullptr; ma.K = 0; ma.rmul = 0; ma.roff = 0; ma.k0 = 0; ma.n0 = 0; ma.q8 = false; ma.sc = 0.f; mb = ma; md = ma;
    const int G_ = (int)gridDim.x; int it = 0, buf = 0;
    const int rp_ = (total / 2) / G_;
#define CVT_TID(i_) ((i_) < 2 * rp_ ? 2 * (c.b + ((i_) >> 1) * G_) + ((i_) & 1) : ((i_) - 2 * rp_ < 2 ? 2 * rp_ * G_ + c.b + ((i_) - 2 * rp_) * G_ : total))
    const int g = c.lane >> 4, li = c.lane & 15, qrow = li >> 2, p = li & 3;
#define CVT_PROC(vc, mc) do { LAS unsigned char* im = img + buf * 32768; \
        if (!mc.q8) { \
            _Pragma("unroll") for (int q = 0; q < 8; ++q) { const int kk = c.wid + 8 * q; const f32x4 e = vc[q] * mc.sc; u32x2 w; w.x = pk2(e[0], e[1]); w.y = pk2(e[2], e[3]); \
                *(LAS u32x2*)(im + kk * 512 + ((c.lane * 8) ^ ((kk & 3) * 32))) = w; } \
            __syncthreads(); \
            _Pragma("unroll") for (int r = 0; r < 4; ++r) { const int nb = (c.wid & 3) + 4 * (g & 1) + 8 * (c.wid >> 2), kc = 2 * r + (g >> 1); \
                const int k = 8 * kc + qrow; const unsigned cb = (unsigned)((32 * nb + 8 * p) ^ (qrow * 32)); \
                const s16x4 a0 = ldtr(im + k * 512 + cb), a1 = ldtr(im + (k + 4) * 512 + cb); \
                u32x4 w; { const u32x2 lo = __builtin_bit_cast(u32x2, a0), hi2 = __builtin_bit_cast(u32x2, a1); w.x = lo.x; w.y = lo.y; w.z = hi2.x; w.w = hi2.y; } \
                *(GAS u32x4*)(uintptr_t)(mc.dst + ((size_t)(mc.n0 + 16 * nb + li) * mc.rmul + mc.roff) * mc.K + mc.k0 + 8 * kc) = w; } \
        } else {                                                     \
            _Pragma("unroll") for (int q2 = 0; q2 < 4; ++q2) { const int jj = c.wid + 8 * q2; const f32x4 e0 = vc[2 * q2] * mc.sc, e1 = vc[2 * q2 + 1] * mc.sc; u32x2 w; \
                { int pa = __builtin_amdgcn_cvt_pk_fp8_f32(e0[0], e1[0], 0, false); pa = __builtin_amdgcn_cvt_pk_fp8_f32(e0[1], e1[1], pa, true); w.x = (unsigned)pa; \
                  int pb = __builtin_amdgcn_cvt_pk_fp8_f32(e0[2], e1[2], 0, false); pb = __builtin_amdgcn_cvt_pk_fp8_f32(e0[3], e1[3], pb, true); w.y = (unsigned)pb; } \
                *(LAS u32x2*)(im + jj * 512 + ((c.lane * 8) ^ ((jj & 3) * 32))) = w; } \
            __syncthreads(); \
            unsigned char* dstb = (unsigned char*)mc.dst; \
            _Pragma("unroll") for (int r = 0; r < 2; ++r) { const int nb = (c.wid & 3) + 4 * (g & 1) + 8 * (c.wid >> 2), kc = 2 * r + (g >> 1);        \
                const int jr = 8 * kc + qrow; const unsigned cb = (unsigned)((32 * nb + 8 * p) ^ (qrow * 32)); \
                const s16x4 a0 = ldtr(im + jr * 512 + cb), a1 = ldtr(im + (jr + 4) * 512 + cb); \
                u32x4 w; { const u32x2 lo = __builtin_bit_cast(u32x2, a0), hi2 = __builtin_bit_cast(u32x2, a1); w.x = lo.x; w.y = lo.y; w.z = hi2.x; w.w = hi2.y; } \
                *(GAS u32x4*)(uintptr_t)(dstb + ((size_t)(mc.n0 + 16 * nb + li) * mc.rmul + mc.roff) * mc.K + mc.k0 + 16 * kc) = w; } \
        } \
        buf ^= 1; } while (0)
    CVT_LOAD(CVT_TID(0), va, ma);
    CVT_LOAD(CVT_TID(1), vb, mb);
    for (;;) {
        if (CVT_TID(it) >= total) break;
        CVT_LOAD(CVT_TID(it + 2), vd, md);
        CVT_PROC(va, ma); ++it;
        if (CVT_TID(it) >= total) break;
        CVT_LOAD(CVT_TID(it + 2), va, ma);
        CVT_PROC(vb, mb); ++it;
        if (CVT_TID(it) >= total) break;
        CVT_LOAD(CVT_TID(it + 2), vb, mb);
        CVT_PROC(vd, md); ++it;
    }
#undef CVT_TID
#undef CVT_PROC
#undef CVT_LOAD
    __syncthreads();
}

template <bool ROUTE, bool XB16, int NROW>
__device__ __forceinline__ void mod_batch(const Args& A, const Ctx& c, const float* xl, const float* xc, int bt, const f32x4 (&pa)[4], const f32x4 (&pb)[4], bf16_t* XN, LAS float* rt, LAS int* cnt) {
    constexpr bool isctx = NROW == 1;
    f32x4 v[NROW][4];
#pragma unroll
    for (int u = 0; u < NROW; ++u) { const float* xr = isctx ? xc + (size_t)c.b * DM : xl + (size_t)(c.b * 64 + c.wid * 8 + bt * 4 + u) * DM;
#pragma unroll
        for (int i = 0; i < 4; ++i) {
            if (XB16 && !isctx) { const u32x2 w = *(const u32x2*)((const bf16_t*)xl + (size_t)(c.b * 64 + c.wid * 8 + bt * 4 + u) * DM + 4 * c.lane + 256 * i); v[u][i] = (f32x4){bflo(w.x), bfhi(w.x), bflo(w.y), bfhi(w.y)}; }
            else v[u][i] = *(const f32x4*)(xr + 4 * c.lane + 256 * i); } }
#pragma unroll
    for (int u = 0; u < NROW; ++u) {
        const int row = isctx ? SEQ + c.b : c.b * 64 + c.wid * 8 + bt * 4 + u;
        float ss = 0.f;
#pragma unroll
        for (int i = 0; i < 4; ++i) ss += v[u][i][0] * v[u][i][0] + v[u][i][1] * v[u][i][1] + v[u][i][2] * v[u][i][2] + v[u][i][3] * v[u][i][3];
        ss = wsum(ss); const float rs = rsqrtf(ss * (1.f / DM) + EPS);
        float lg[8];
#pragma unroll
        for (int e = 0; e < 8; ++e) lg[e] = 0.f;
#pragma unroll
        for (int i = 0; i < 4; ++i) { const int col = 4 * c.lane + 256 * i;
            const f32x4 y = v[u][i] * rs * pa[i] + pb[i];
            if (ROUTE) *(unsigned*)((unsigned char*)XN + (size_t)row * DM + col) = pk4_fp8(y[0], y[1], y[2], y[3]);
            else { u32x2 w; w.x = pk2(y[0], y[1]); w.y = pk2(y[2], y[3]); *(u32x2*)(XN + (size_t)row * DM + col) = w; }
            if (ROUTE) {
#pragma unroll
                for (int e = 0; e < 8; ++e) { const f32x4 r = *(const LAS f32x4*)(rt + e * 1024 + col); lg[e] += y[0] * r[0] + y[1] * r[1] + y[2] * r[2] + y[3] * r[3]; } } }
        if (ROUTE) {
#pragma unroll
            for (int e = 0; e < 8; ++e) lg[e] = wsum(lg[e]);
            if (c.lane == 0) { int i0 = 0; float v0 = lg[0];
#pragma unroll
                for (int e = 1; e < 8; ++e) if (lg[e] > v0) { v0 = lg[e]; i0 = e; }
                int i1 = 0; float v1 = -INFINITY;
#pragma unroll
                for (int e = 0; e < 8; ++e) if (e != i0 && lg[e] > v1) { v1 = lg[e]; i1 = e; }
                const float e1 = __expf(v1 - v0), w0 = 1.f / (1.f + e1);
                WSP(int, WS_TOKE)[row * 2] = i0; WSP(int, WS_TOKE)[row * 2 + 1] = i1; WSP(float, WS_TOKW)[row * 2] = w0; WSP(float, WS_TOKW)[row * 2 + 1] = e1 * w0;
                atomicAdd((int*)(cnt + i0), 1); atomicAdd((int*)(cnt + i1), 1); } }
    }
}
template <bool HAS_CTX, bool ROUTE, bool XB16 = false>
__device__ __forceinline__ void ph_modulate(const Args& A, const Ctx& c, const float* xl, const float* xc, const float* g, const float* mod_l, const float* mod_c, int ish, int isc) {
    bf16_t* XN = WSP(bf16_t, WS_XN);
    LAS float* rt = (LAS float*)c.lds;
    LAS int* cnt = (LAS int*)(c.lds + 32768);
    if (ROUTE) { for (int i = c.tid; i < 2048; i += NTHR) { const f32x4 r = *(const f32x4*)(A.in[30] + i * 4); const int d = i >> 1, e0 = (i & 1) * 4;
                     rt[(e0 + 0) * 1024 + d] = r[0]; rt[(e0 + 1) * 1024 + d] = r[1]; rt[(e0 + 2) * 1024 + d] = r[2]; rt[(e0 + 3) * 1024 + d] = r[3]; }
                 if (c.tid < 8) cnt[c.tid] = 0;
                 if (c.b == 0) { for (int i = c.tid; i < 256; i += NTHR) *(unsigned*)((unsigned char*)XN + (size_t)ZROW * DM + i * 4) = 0u; }
                 __syncthreads(); }
    const bool has_c = HAS_CTX && c.wid == (c.b & 7);
    f32x4 pa[4], pb[4];
#pragma unroll
    for (int i = 0; i < 4; ++i) { const int col = 4 * c.lane + 256 * i; pa[i] = *(const f32x4*)(g + col) * (*(const f32x4*)(mod_l + isc * DM + col) + 1.f); pb[i] = *(const f32x4*)(mod_l + ish * DM + col); }
    f32x4 pca[4], pcb[4];
#pragma unroll
    for (int i = 0; i < 4; ++i) { const int col = 4 * c.lane + 256 * i; pca[i] = pa[i]; pcb[i] = pb[i];
        if (HAS_CTX) { pca[i] = *(const f32x4*)(g + col) * (*(const f32x4*)(mod_c + isc * DM + col) + 1.f); pcb[i] = *(const f32x4*)(mod_c + ish * DM + col); } }
    for (int bt = 0; bt < 2; ++bt) mod_batch<ROUTE, XB16, 4>(A, c, xl, xc, bt, pa, pb, XN, rt, cnt);
    if (has_c) mod_batch<ROUTE, XB16, 1>(A, c, xl, xc, 2, pca, pcb, XN, rt, cnt);
    if (ROUTE) { __syncthreads(); if (c.tid < 8) WSP(int, WS_CNTG)[c.b * 8 + c.tid] = cnt[c.tid]; __syncthreads(); }
}

__device__ __forceinline__ void ph_plan(const Args& A, const Ctx& c) {
    LAS int* call = (LAS int*)c.lds;
    LAS int* tot = call + 2048; LAS int* myb = tot + 8; LAS int* eb = myb + 8; LAS int* te = eb + 16;
    for (int i = c.tid; i < 2048; i += NTHR) call[i] = WSP(int, WS_CNTG)[i];
    if (c.tid < 128) te[c.tid] = WSP(int, WS_TOKE)[c.b * 128 + c.tid];
    __syncthreads();
    { LAS int* ps = te + 128;
      if (c.tid < 256) { const int e = c.tid & 7, part = c.tid >> 3; int t = 0, mb = 0;
#pragma unroll
          for (int k = 0; k < 8; ++k) { const int bb = part * 8 + k; const int q = call[bb * 8 + e]; if (bb < c.b) mb += q; t += q; }
          ps[(part * 8 + e) * 2] = t; ps[(part * 8 + e) * 2 + 1] = mb; }
      __syncthreads();
      if (c.tid < 8) { int t = 0, mb = 0; for (int part = 0; part < 32; ++part) { t += ps[(part * 8 + c.tid) * 2]; mb += ps[(part * 8 + c.tid) * 2 + 1]; } tot[c.tid] = t; myb[c.tid] = mb; } }
    __syncthreads();
    if (c.tid == 0) { int s = 0; for (int e = 0; e < 8; ++e) { eb[e] = s; s += (tot[e] + 255) / 256 * 256; } eb[8] = s; }
    __syncthreads();
    unsigned* rowt = WSP(unsigned, WS_ROWT);
    { LAS int* w0cnt = te + 128 + 512;
      int rank = 0, e = 0;
      if (c.tid < 128) { e = te[c.tid];
#pragma unroll
          for (int k = 0; k < 8; ++k) { const unsigned long long m = __ballot(e == k); if (e == k) rank = __popcll(m & ((1ull << c.lane) - 1ull)); if (c.tid < 64 && c.lane == 0) w0cnt[k] = __popcll(m); } }
      __syncthreads();
      if (c.tid < 128) { const int pos = eb[e] + myb[e] + rank + (c.tid >= 64 ? w0cnt[e] : 0);
          rowt[pos] = (unsigned)(c.b * 64 + (c.tid >> 1)) * 1024u; WSP(int, WS_TOKS)[c.b * 128 + c.tid] = pos; } }
    if (c.b < 8) { for (int s = eb[c.b] + tot[c.b] + c.tid; s < eb[c.b + 1]; s += NTHR) rowt[s] = (unsigned)ZROW * 1024u; }
    if (c.b == 8 && c.tid < 256) { int e = 0;
        if (c.tid < 136) { e = -1;
#pragma unroll
            for (int k = 0; k < 8; ++k) if (c.tid * 256 >= eb[k] && c.tid * 256 < eb[k + 1]) e = k; }
        if (c.tid == 255) e = eb[8] / 256;
        WSP(int, WS_TILE)[c.tid] = e; }
    __syncthreads();
}

constexpr int WS_SPLITCNT = 3456;
__device__ __forceinline__ void moe_split_fixup(const Args& A, const Ctx& c, int F, int S) {
    const int q = c.b / S, s = c.b % S; unsigned* cnt = WSP(unsigned, WS_BAR) + WS_SPLITCNT + 16 * q;
    asm volatile("s_waitcnt vmcnt(0)" ::: "memory");
    __syncthreads();
    if (c.tid == 0) { __builtin_amdgcn_fence(__ATOMIC_RELEASE, "agent"); xb_add(cnt, 1u);
        while (xb_ld(cnt) < (unsigned)S) __builtin_amdgcn_s_sleep(1);
        __builtin_amdgcn_fence(__ATOMIC_ACQUIRE, "agent"); }
    __syncthreads();
    const int pm = (F >> 2) + (q >> 2), pc = q & 3; const float* P = WSP(float, WS_PART) + (size_t)(q * S) * 65536; bf16_t* Y = WSP(bf16_t, WS_Y);
    const int lo = (int)(((long)s * 16384) / S), hi = (int)(((long)(s + 1) * 16384) / S);
    for (int e = lo + c.tid; e < hi; e += NTHR) { f32x4 a = *(const f32x4*)(P + (size_t)e * 4);
        for (int k = 1; k < S; ++k) a = a + *(const f32x4*)(P + (size_t)k * 65536 + (size_t)e * 4);
        a = a * (1.f / 64.f);
        const int row = e >> 6, col = (e & 63) * 4; u32x2 w; w.x = pk2(a[0], a[1]); w.y = pk2(a[2], a[3]);
        *(u32x2*)(Y + (size_t)(pm * 256 + row) * DM + pc * 256 + col) = w; }
}

__device__ __forceinline__ void ph_combine(const Args& A, const Ctx& c) {
    const float* g5 = WSP(float, WS_MOD) + 2 * 6144 + 5 * DM; const bf16_t* Y = WSP(bf16_t, WS_Y); const bf16_t* XB = WSP(bf16_t, WS_XB);
    const int tb = c.b * 64 + c.wid * 8;
    f32x4 ghv[4];
#pragma unroll
    for (int i = 0; i < 4; ++i) ghv[i] = *(const f32x4*)(g5 + 4 * c.lane + 256 * i);
    for (int q0 = 0; q0 < 8; q0 += 4) {
        int sl[4][2]; float wt[4][2];
#pragma unroll
        for (int u = 0; u < 4; ++u) { const int t = tb + q0 + u; sl[u][0] = WSP(int, WS_TOKS)[t * 2]; sl[u][1] = WSP(int, WS_TOKS)[t * 2 + 1]; wt[u][0] = WSP(float, WS_TOKW)[t * 2]; wt[u][1] = WSP(float, WS_TOKW)[t * 2 + 1]; }
        u32x2 ya[4][4], yb[4][4], xx[4][4];
#pragma unroll
        for (int u = 0; u < 4; ++u)
#pragma unroll
            for (int i = 0; i < 4; ++i) { const int col = 4 * c.lane + 256 * i;
                ya[u][i] = *(const u32x2*)(Y + (size_t)sl[u][0] * DM + col); yb[u][i] = *(const u32x2*)(Y + (size_t)sl[u][1] * DM + col); xx[u][i] = *(const u32x2*)(XB + (size_t)(tb + q0 + u) * DM + col); }
#pragma unroll
        for (int u = 0; u < 4; ++u)
#pragma unroll
            for (int i = 0; i < 4; ++i) { const int col = 4 * c.lane + 256 * i; const f32x4 gg = ghv[i]; f32x4 x = (f32x4){bflo(xx[u][i].x), bfhi(xx[u][i].x), bflo(xx[u][i].y), bfhi(xx[u][i].y)}; const float w0 = wt[u][0], w1 = wt[u][1];
                x[0] += gg[0] * (w0 * bflo(ya[u][i].x) + w1 * bflo(yb[u][i].x)); x[1] += gg[1] * (w0 * bfhi(ya[u][i].x) + w1 * bfhi(yb[u][i].x));
                x[2] += gg[2] * (w0 * bflo(ya[u][i].y) + w1 * bflo(yb[u][i].y)); x[3] += gg[3] * (w0 * bfhi(ya[u][i].y) + w1 * bfhi(yb[u][i].y));
                *(f32x4*)(A.out + (size_t)(tb + q0 + u) * DM + col) = x; }
    }
}

__device__ __forceinline__ void ctx_gemm_resid(const Ctx& c, const bf16_t* Actx, int lda, const bf16_t* Bt, int K, const float* xin, float* xout, const float* gate) {
    const int tr = c.b >> 5, tc = c.b & 31, r32 = c.lane & 31, hi = c.lane >> 5, K8 = K >> 3;
    const bf16_t* ap = Actx + (size_t)(32 * tr + r32) * lda + 8 * hi + c.wid * K8; const bf16_t* bp = Bt + (size_t)(32 * tc + r32) * K + 8 * hi + c.wid * K8;
    f32x16 acc = (f32x16){};
#pragma unroll 8
    for (int k0 = 0; k0 < K8; k0 += 16) { const bf16x8 av = *(const bf16x8*)(ap + k0), bv = *(const bf16x8*)(bp + k0); acc = MFMA32(bv, av, acc); }
    LAS float* ex = (LAS float*)c.lds;
#pragma unroll
    for (int r = 0; r < 16; ++r) ex[(c.wid * 16 + r) * 64 + c.lane] = acc[r];
    __syncthreads();
#pragma unroll
    for (int q = 0; q < 2; ++q) { const int r = 2 * c.wid + q; float s = 0.f;
#pragma unroll
        for (int w = 0; w < 8; ++w) s += ex[(w * 16 + r) * 64 + c.lane];
        const int col = 32 * tc + crow(r, hi); const size_t off = (size_t)(32 * tr + r32) * DM + col;
        xout[off] = xin[off] + gate[col] * s; }
    __syncthreads();
}

__device__ __forceinline__ void ph_rope_table(const Args& A, const Ctx& c) {
    float2* T = WSP(float2, WS_ROPE);
    for (int e = c.b * NTHR + c.tid; e < 4096; e += (int)gridDim.x * NTHR) { const int pos = e >> 4, f = e & 15;
        const float invf = powf(10000.f, -(float)(2 * f) * (1.f / 32.f)); const float ang = (float)pos * invf; T[e] = make_float2(cosf(ang), sinf(ang)); }
}
__device__ __forceinline__ void rope_pair(float& x0, float& x1, const float2* T, int pos, int f) {
    const float2 cs = T[pos * 16 + f];
    const float a = x0 * cs.x - x1 * cs.y, b2 = x0 * cs.y + x1 * cs.x; x0 = a; x1 = b2;
}

__device__ __forceinline__ void ph_kprep0(const Args& A, const Ctx& c) {
    const bf16_t* P0 = WSP(bf16_t, WS_P0); bf16_t* KP = WSP(bf16_t, WS_KP); const float* kg = A.in[11];
    if (c.b < 8) return;
    const int stride = ((int)gridDim.x - 8) * 8, kvh = c.lane >> 5, pr = c.lane & 31; const float g0 = kg[2 * pr], g1 = kg[2 * pr + 1];
    for (int base = (c.b - 8) * 8 + c.wid; base < ROWS; base += stride * 4) {
        unsigned w[4]; float2 cs[4];
#pragma unroll
        for (int u = 0; u < 4; ++u) { const int row = base + u * stride < ROWS ? base + u * stride : 0; w[u] = *(const unsigned*)(P0 + (size_t)row * 2816 + 2560 + 2 * c.lane);
            const int rr = row < SEQ ? row : 0; cs[u] = WSP(float2, WS_ROPE)[(pr < 16 ? rr / 64 : rr % 64) * 16 + (pr & 15)]; if (row >= SEQ) cs[u] = make_float2(1.f, 0.f); }
#pragma unroll
        for (int u = 0; u < 4; ++u) { const int row = base + u * stride; if (row < ROWS) {
            float x0 = bflo(w[u]), x1 = bfhi(w[u]); float ss = x0 * x0 + x1 * x1;
            ss += __shfl_xor(ss, 1); ss += __shfl_xor(ss, 2); ss += __shfl_xor(ss, 4); ss += __shfl_xor(ss, 8); ss += __shfl_xor(ss, 16);
            const float rs = rsqrtf(ss * (1.f / 64.f) + EPS); x0 *= rs * g0; x1 *= rs * g1;
            { const float a = x0 * cs[u].x - x1 * cs[u].y, b2 = x0 * cs[u].y + x1 * cs[u].x; x0 = a; x1 = b2; }
            *(unsigned*)(KP + (size_t)row * 128 + kvh * 64 + 2 * pr) = pk2(x0, x1); } }
    }
}
__device__ __forceinline__ void ph_prep1a(const Args& A, const Ctx& c) {
    bf16_t* P1 = WSP(bf16_t, WS_P1); bf16_t* KR = WSP(bf16_t, WS_KR); const float* gq = A.in[21]; const float* gkv = A.in[22]; const float* gkr = A.in[28];
    const int stride = gridDim.x * 8;
    float hq[3][2], hkv[2][2], hkr[2];
#pragma unroll
    for (int i = 0; i < 3; ++i) { hq[i][0] = gq[2 * c.lane + 128 * i]; hq[i][1] = gq[2 * c.lane + 128 * i + 1]; }
#pragma unroll
    for (int i = 0; i < 2; ++i) { hkv[i][0] = gkv[2 * c.lane + 128 * i]; hkv[i][1] = gkv[2 * c.lane + 128 * i + 1]; }
    hkr[0] = gkr[(2 * c.lane) & 31]; hkr[1] = gkr[(2 * c.lane + 1) & 31];
    for (int base = c.b * 8 + c.wid; base < ROWS; base += stride * 4) {
        unsigned wq[4][3], wk[4][2], wr[4]; float2 csr[4];
#pragma unroll
        for (int u = 0; u < 4; ++u) { const int row = base + u * stride; const bf16_t* pr = P1 + (size_t)(row < ROWS ? row : 0) * 768;
#pragma unroll
            for (int i = 0; i < 3; ++i) wq[u][i] = *(const unsigned*)(pr + 2 * c.lane + 128 * i);
#pragma unroll
            for (int i = 0; i < 2; ++i) wk[u][i] = *(const unsigned*)(pr + 384 + 2 * c.lane + 128 * i);
            wr[u] = c.lane < 16 ? *(const unsigned*)(pr + 640 + 2 * c.lane) : 0u;
            { const int rr = row < SEQ ? row : 0; csr[u] = WSP(float2, WS_ROPE)[(c.lane < 8 ? rr / 64 : rr % 64) * 16 + 2 * (c.lane & 7)]; if (row >= SEQ) csr[u] = make_float2(1.f, 0.f); } }
#pragma unroll
        for (int u = 0; u < 4; ++u) { const int row = base + u * stride; if (row < ROWS) { bf16_t* pr = P1 + (size_t)row * 768;
            if (row < SEQ) { float ss = 0.f;
#pragma unroll
                for (int i = 0; i < 3; ++i) { const float a0 = bflo(wq[u][i]), a1 = bfhi(wq[u][i]); ss += a0 * a0 + a1 * a1; }
                ss = wsum(ss); const float rs = rsqrtf(ss * (1.f / 384.f) + EPS);
#pragma unroll
                for (int i = 0; i < 3; ++i) { const int col = 2 * c.lane + 128 * i; *(unsigned*)(pr + col) = pk2(bflo(wq[u][i]) * rs * hq[i][0], bfhi(wq[u][i]) * rs * hq[i][1]); } }
            { float ss = 0.f;
#pragma unroll
                for (int i = 0; i < 2; ++i) { const float a0 = bflo(wk[u][i]), a1 = bfhi(wk[u][i]); ss += a0 * a0 + a1 * a1; }
                ss = wsum(ss); const float rs = rsqrtf(ss * (1.f / 256.f) + EPS);
#pragma unroll
                for (int i = 0; i < 2; ++i) { const int col = 2 * c.lane + 128 * i; *(unsigned*)(pr + 384 + col) = pk2(bflo(wk[u][i]) * rs * hkv[i][0], bfhi(wk[u][i]) * rs * hkv[i][1]); } }
            { float x0 = bflo(wr[u]), x1 = bfhi(wr[u]);
                const float ss = wsum(x0 * x0 + x1 * x1); const float rs = rsqrtf(ss * (1.f / 32.f) + EPS);
                if (c.lane < 16) { x0 *= rs * hkr[0]; x1 *= rs * hkr[1];
                    { const float a = x0 * csr[u].x - x1 * csr[u].y, b2 = x0 * csr[u].y + x1 * csr[u].x; x0 = a; x1 = b2; }
                    *(unsigned*)(KR + (size_t)row * 32 + 2 * c.lane) = pk2(x0, x1); } } } }
    }
}
__device__ __forceinline__ void ph_prep1b(const Args& A, const Ctx& c) {
    const bf16_t* KV = WSP(bf16_t, WS_KV1); const bf16_t* KR = WSP(bf16_t, WS_KR); bf16_t* K1 = WSP(bf16_t, WS_K1); const float* gk = A.in[27];
    const int stride = gridDim.x * 8, h = c.lane >> 3, part = c.lane & 7, hr = c.lane >> 2, pr = c.lane & 3;
    const f32x4 ga = *(const f32x4*)(gk + part * 8), gb = *(const f32x4*)(gk + part * 8 + 4);
    for (int base = c.b * 8 + c.wid; base < ROWS; base += stride * 4) {
        u32x4 w[4], kr[4];
#pragma unroll
        for (int u = 0; u < 4; ++u) { const int row = base + u * stride < ROWS ? base + u * stride : 0;
            w[u] = *(const u32x4*)(KV + (size_t)row * 1024 + h * 128 + part * 8); kr[u] = (u32x4){0u, 0u, 0u, 0u};
            if (c.lane < 32) kr[u] = *(const u32x4*)(KR + (size_t)row * 32 + pr * 8); }
#pragma unroll
        for (int u = 0; u < 4; ++u) { const int row = base + u * stride; if (row < ROWS) {
            float x[8]; float ss = 0.f;
#pragma unroll
            for (int k = 0; k < 4; ++k) { x[2 * k] = bflo(w[u][k]); x[2 * k + 1] = bfhi(w[u][k]); ss += x[2 * k] * x[2 * k] + x[2 * k + 1] * x[2 * k + 1]; }
            ss += __shfl_xor(ss, 1); ss += __shfl_xor(ss, 2); ss += __shfl_xor(ss, 4);
            const float rs = rsqrtf(ss * (1.f / 64.f) + EPS);
            u32x4 o; o.x = pk2(x[0] * rs * ga[0], x[1] * rs * ga[1]); o.y = pk2(x[2] * rs * ga[2], x[3] * rs * ga[3]); o.z = pk2(x[4] * rs * gb[0], x[5] * rs * gb[1]); o.w = pk2(x[6] * rs * gb[2], x[7] * rs * gb[3]);
            *(u32x4*)(K1 + (size_t)row * 768 + h * 96 + part * 8) = o;
            if (c.lane < 32) *(u32x4*)(K1 + (size_t)row * 768 + hr * 96 + 64 + pr * 8) = kr[u]; } }
    }
}

__device__ __forceinline__ int ret_rowbase(int ck) { return ck < 2 ? SEQ + 128 * ck : 128 * (ck - 2); }
__device__ __forceinline__ unsigned swzV(int m, int cbyte) { return (unsigned)(m * 128 + (cbyte ^ (((m >> 1) & 1) * 64))); }

__device__ __forceinline__ void ph_ret1(const Args& A, const Ctx& c) {
    const bf16_t* P0 = WSP(bf16_t, WS_P0); float* U = WSP(float, WS_RETU); const float* ld = A.in[9];
    const int r32 = c.lane & 31, hi = c.lane >> 5;
    for (int unit = c.b; unit < NCHUNK * 4; unit += gridDim.x) { const int ck = unit >> 2, hp = unit & 3, rb = ret_rowbase(ck);
#pragma unroll
        for (int q = 0; q < 4; ++q) { const int id = c.tid + NTHR * q; const int hl = id >> 10, m = (id >> 3) & 127, ch = id & 7, h = hp * 2 + hl;
            const bf16_t* src = P0 + (size_t)(rb + m) * 2816 + h * 64 + ch * 8;
            const u32x4 kw = *(const u32x4*)(src + 512), vw = *(const u32x4*)(src + 1024);
            const float zf = fexp2((float)(127 - m) * ld[h] * LOG2E), zb = fexp2((float)m * ld[8 + h] * LOG2E);
            u32x4 vf, vb;
#pragma unroll
            for (int k = 0; k < 4; ++k) { const float lo = bflo(vw[k]), hh = bfhi(vw[k]); vf[k] = pk2(lo * zf, hh * zf); vb[k] = pk2(lo * zb, hh * zb); }
            LAS unsigned char* base = c.lds + hl * 49152; const unsigned o = swzV(m, ch * 16);
            *(LAS u32x4*)(base + o) = kw; *(LAS u32x4*)(base + 16384 + o) = vf; *(LAS u32x4*)(base + 32768 + o) = vb; }
        __syncthreads();
        { const int hl = c.wid >> 2, dir = (c.wid >> 1) & 1, eblk = c.wid & 1, h = hp * 2 + hl;
          LAS const unsigned char* Kim = c.lds + hl * 49152; LAS const unsigned char* Vim = Kim + 16384 + dir * 16384;
          const int qrow = (c.lane & 15) >> 2, p = c.lane & 3, ebit = (c.lane >> 4) & 1;
          f32x16 acc[2]; acc[0] = (f32x16){}; acc[1] = (f32x16){};
#pragma unroll
          for (int ks = 0; ks < 8; ++ks) { const int m0 = 16 * ks + 4 * hi + qrow, m1 = m0 + 8;
              const s16x4 a0 = ldtr(Vim + swzV(m0, 64 * eblk + 32 * ebit + 8 * p)), a1 = ldtr(Vim + swzV(m1, 64 * eblk + 32 * ebit + 8 * p));
              const bf16x8 af = (bf16x8){a0[0], a0[1], a0[2], a0[3], a1[0], a1[1], a1[2], a1[3]};
#pragma unroll
              for (int db = 0; db < 2; ++db) { const s16x4 b0 = ldtr(Kim + swzV(m0, 64 * db + 32 * ebit + 8 * p)), b1 = ldtr(Kim + swzV(m1, 64 * db + 32 * ebit + 8 * p));
                  const bf16x8 bfr = (bf16x8){b0[0], b0[1], b0[2], b0[3], b1[0], b1[1], b1[2], b1[3]};
                  acc[db] = MFMA32(af, bfr, acc[db]); } }
          float* up = U + ((size_t)((dir * 8 + h) * NCHUNK + ck)) * 4096;
#pragma unroll
          for (int db = 0; db < 2; ++db)
#pragma unroll
              for (int r = 0; r < 16; ++r) up[(32 * eblk + crow(r, hi)) * 64 + 32 * db + r32] = acc[db][r]; }
        __syncthreads();
    }
}
__device__ __forceinline__ void ph_retscan(const Args& A, const Ctx& c) {
    if (c.tid >= 256) return;
    const float* U = WSP(float, WS_RETU); bf16_t* St = WSP(bf16_t, WS_RETS); const float* ld = A.in[9];
    const int idx = c.b * 256 + c.tid, dh = idx >> 12, el = idx & 4095, dir = dh >> 3;
    const float g = fexp2(128.f * ld[dh] * LOG2E);
    const float* up = U + (size_t)dh * NCHUNK * 4096 + el; bf16_t* sp = St + (size_t)dh * NCHUNK * 4096 + el;
    float s = 0.f;
#pragma unroll 26
    for (int i = 0; i < NCHUNK; ++i) { const int ck = dir == 0 ? i : (i == 0 ? 1 : (i == 1 ? 0 : 131 - i));
        const float u = up[(size_t)ck * 4096]; sp[(size_t)ck * 4096] = (bf16_t)(pk2(s, 0.f) & 0xffff); s = g * s + u; }
}
__device__ __forceinline__ void ph_ret2_unit(const Args& A, const Ctx& c, int unit) {
    const bf16_t* P0 = WSP(bf16_t, WS_P0); const bf16_t* St = WSP(bf16_t, WS_RETS); bf16_t* CAT = WSP(bf16_t, WS_CAT); const float* ld = A.in[9];
    const int r32 = c.lane & 31, hi = c.lane >> 5;
    const int ck = unit >> 2, hp = unit & 3, rb = ret_rowbase(ck);
    const int hl = c.wid >> 2, strip = c.wid & 3, h = hp * 2 + hl; const int cq = 32 * strip + r32, row = rb + cq;
    u32x4 kw[4], vw[4];
#pragma unroll
    for (int q = 0; q < 4; ++q) { const int id = c.tid + NTHR * q; const int hl2 = id >> 10, m = (id >> 3) & 127, ch = id & 7, h2 = hp * 2 + hl2;
        const bf16_t* src = P0 + (size_t)(rb + m) * 2816 + h2 * 64 + ch * 8; kw[q] = *(const u32x4*)(src + 512); vw[q] = *(const u32x4*)(src + 1024); }
    bf16x8 qf[4], sff[2][4], sbf[2][4]; u32x2 gw[2][4];
#pragma unroll
    for (int d0 = 0; d0 < 4; ++d0) qf[d0] = *(const bf16x8*)(P0 + (size_t)row * 2816 + h * 64 + d0 * 16 + hi * 8);
#pragma unroll
    for (int eb = 0; eb < 2; ++eb) { const bf16_t* sf = St + ((size_t)(h * NCHUNK + ck)) * 4096 + (32 * eb + r32) * 64 + hi * 8; const bf16_t* sb = sf + (size_t)8 * NCHUNK * 4096;
#pragma unroll
        for (int d0 = 0; d0 < 4; ++d0) { sff[eb][d0] = *(const bf16x8*)(sf + d0 * 16); sbf[eb][d0] = *(const bf16x8*)(sb + d0 * 16); }
#pragma unroll
        for (int rq = 0; rq < 4; ++rq) gw[eb][rq] = *(const u32x2*)(P0 + (size_t)row * 2816 + 1536 + h * 64 + 32 * eb + 8 * rq + 4 * hi); }
#pragma unroll
    for (int q = 0; q < 4; ++q) { const int id = c.tid + NTHR * q; const int hl2 = id >> 10, m = (id >> 3) & 127, ch = id & 7;
        LAS unsigned char* base = c.lds + hl2 * 34816;
        *(LAS u32x4*)(base + m * 144 + ch * 16) = kw[q]; *(LAS u32x4*)(base + 18432 + swzV(m, ch * 16)) = vw[q]; }
    __syncthreads();
    { LAS const unsigned char* Kim = c.lds + hl * 34816; LAS const unsigned char* Vim = Kim + 18432;
      const float lf2 = ld[h] * LOG2E, lb2 = ld[8 + h] * LOG2E;
      const float xf = fexp2((float)(cq + 1) * lf2), xb = fexp2((float)(128 - cq) * lb2);
      f32x16 o[2];
#pragma unroll
      for (int eb = 0; eb < 2; ++eb) {
          f32x16 t = (f32x16){};
#pragma unroll
          for (int d0 = 0; d0 < 4; ++d0) t = MFMA32(sff[eb][d0], qf[d0], t);
#pragma unroll
          for (int r = 0; r < 16; ++r) o[eb][r] = xf * t[r];
          t = (f32x16){};
#pragma unroll
          for (int d0 = 0; d0 < 4; ++d0) t = MFMA32(sbf[eb][d0], qf[d0], t);
#pragma unroll
          for (int r = 0; r < 16; ++r) o[eb][r] += xb * t[r]; }
      const int qrow = (c.lane & 15) >> 2, p = c.lane & 3, ebit = (c.lane >> 4) & 1;
#pragma unroll 2
      for (int blk = 0; blk < 4; ++blk) { f32x16 s = (f32x16){};
#pragma unroll
          for (int d0 = 0; d0 < 4; ++d0) s = MFMA32(*(const LAS bf16x8*)(Kim + (32 * blk + r32) * 144 + (2 * d0 + hi) * 16), qf[d0], s);
#pragma unroll
          for (int r = 0; r < 16; ++r) { const int dl = cq - (32 * blk + crow(r, hi));
              const float w = dl > 0 ? fexp2((float)dl * lf2) : (dl < 0 ? fexp2((float)(-dl) * lb2) : 2.f); s[r] *= w; }
#pragma unroll
          for (int half = 0; half < 2; ++half) { const int g = blk * 2 + half;
              u32x4 pw; pw.x = pk2(s[8 * half + 0], s[8 * half + 1]); pw.y = pk2(s[8 * half + 2], s[8 * half + 3]); pw.z = pk2(s[8 * half + 4], s[8 * half + 5]); pw.w = pk2(s[8 * half + 6], s[8 * half + 7]);
              const bf16x8 pf = __builtin_bit_cast(bf16x8, pw);
              const int m0 = 16 * g + 4 * hi + qrow, m1 = m0 + 8;
#pragma unroll
              for (int eb = 0; eb < 2; ++eb) { const s16x4 a0 = ldtr(Vim + swzV(m0, 64 * eb + 32 * ebit + 8 * p)), a1 = ldtr(Vim + swzV(m1, 64 * eb + 32 * ebit + 8 * p));
                  const bf16x8 af = (bf16x8){a0[0], a0[1], a0[2], a0[3], a1[0], a1[1], a1[2], a1[3]};
                  o[eb] = MFMA32(af, pf, o[eb]); } } }
      float sm = 0.f;
#pragma unroll
      for (int eb = 0; eb < 2; ++eb)
#pragma unroll
          for (int r = 0; r < 16; ++r) sm += o[eb][r];
      sm += xhalf(sm); const float mu = sm * (1.f / 64.f); float vq = 0.f;
#pragma unroll
      for (int eb = 0; eb < 2; ++eb)
#pragma unroll
          for (int r = 0; r < 16; ++r) { const float d = o[eb][r] - mu; vq += d * d; }
      vq += xhalf(vq); const float rs = rsqrtf(vq * (1.f / 64.f) + EPS);
#pragma unroll
      for (int eb = 0; eb < 2; ++eb)
#pragma unroll
          for (int rq = 0; rq < 4; ++rq) { const int e0 = 32 * eb + 8 * rq + 4 * hi; const u32x2 g2 = gw[eb][rq];
              const float y0 = (o[eb][4 * rq + 0] - mu) * rs * fsilu(bflo(g2.x)), y1 = (o[eb][4 * rq + 1] - mu) * rs * fsilu(bfhi(g2.x));
              const float y2 = (o[eb][4 * rq + 2] - mu) * rs * fsilu(bflo(g2.y)), y3 = (o[eb][4 * rq + 3] - mu) * rs * fsilu(bfhi(g2.y));
              u32x2 w; w.x = pk2(y0, y1); w.y = pk2(y2, y3); *(u32x2*)(CAT + (size_t)row * 1024 + h * 64 + e0) = w; } }
    __syncthreads();
}

__device__ __forceinline__ float max3f(float a, float b, float c) { return __builtin_fmaxf(__builtin_fmaxf(a, b), c); }
__device__ __forceinline__ float rowmax32(const f32x16& p0, const f32x16& p1) {
    float a = max3f(p0[0], p0[1], p1[0]), b = max3f(p0[2], p0[3], p1[1]); a = max3f(a, p1[2], p1[3]);
#pragma unroll
    for (int r = 4; r < 16; r += 4) { a = max3f(a, p0[r], p0[r + 1]); b = max3f(b, p0[r + 2], p0[r + 3]); a = max3f(a, p1[r], p1[r + 1]); b = max3f(b, p1[r + 2], p1[r + 3]); }
    float m; asm("v_max_f32_e32 %0, %1, %2" : "=v"(m) : "v"(a), "v"(b));
    auto rr = __builtin_amdgcn_permlane32_swap(__float_as_uint(m), __float_as_uint(m), false, false);
    float r2; asm("v_max_f32_e32 %0, %1, %2" : "=v"(r2) : "v"(__uint_as_float(rr[0])), "v"(__uint_as_float(rr[1]))); return r2;
}
__device__ __forceinline__ void glds16(const void* gsrc, unsigned lds_dst) { unsigned keep;
    asm volatile("s_mov_b32 %0, m0\n\ts_mov_b32 m0, %2\n\ts_nop 0\n\tglobal_load_lds_dwordx4 %1, off\n\ts_mov_b32 m0, %0" : "=&s"(keep) : "v"(gsrc), "s"(lds_dst) : "memory"); }
__device__ __forceinline__ float gain_sq(const float* g, int n, int lane) { float m = 0.f; for (int i = lane; i < n; i += 64) m = fmaxf(m, fabsf(g[i]));
#pragma unroll
    for (int o = 32; o >= 1; o >>= 1) m = fmaxf(m, __shfl_xor(m, o));
    return m * m * (float)n; }
struct AttnArgs { const bf16_t* Q; int qpitch; const bf16_t* K; int kpitch; const bf16_t* V; int vpitch; bf16_t* O; int opitch; int q0, key0, ntiles; bool rope; const float* g1; const float* g2; };
template <int MODE, bool FIXED>
__device__ __forceinline__ void attn_unit(const Ctx& c, const AttnArgs& a, float sbound) {
    constexpr int DQ = MODE == 0 ? 64 : 96, ND = DQ / 16, KP = DQ * 2 + 16, KB = 64 * KP, NKB = KB / 1024, CPR = DQ / 8;
    constexpr int KR = 0, VR = 3 * KB, DUM = VR + 3 * 8192;
    constexpr float SCALE = (MODE == 0 ? 0.125f : 0.10206207261596575f) * LOG2E, THR = 8.f;
    const int r32 = c.lane & 31, hi = c.lane >> 5; const int qrow = a.q0 + c.wid * 32 + r32;
    unsigned koff1, koff2, voff; const bool has2 = (8 + c.wid) < NKB;
    { const int o1 = 1024 * c.wid + 16 * c.lane, row1 = o1 / KP, ch1 = (o1 % KP) / 16; koff1 = (unsigned)(row1 * a.kpitch * 2 + (ch1 < CPR ? ch1 : 0) * 16);
      const int o2 = 1024 * (8 + c.wid) + 16 * c.lane, row2 = o2 / KP, ch2 = (o2 % KP) / 16; koff2 = has2 ? (unsigned)(row2 * a.kpitch * 2 + (ch2 < CPR ? ch2 : 0) * 16) : koff1;
      const int vrow = 8 * c.wid + (c.lane >> 3), pc = c.lane & 7, lc = pc ^ (4 * ((vrow >> 1) & 1)); voff = (unsigned)(vrow * a.vpitch * 2 + lc * 16); }
    const unsigned kd1 = (unsigned)(KR + 1024 * c.wid), kd2 = has2 ? (unsigned)(KR + 1024 * (8 + c.wid)) : 0u, vd = (unsigned)(VR + 1024 * c.wid);
    const int ntm1 = a.ntiles - 1; const unsigned lds0 = (unsigned)(uintptr_t)c.lds;
#define ATT_CL(x) ((x) < ntm1 ? (x) : ntm1)
#define ATT_DMAK(t, slot) do { const char* kb_ = (const char*)a.K + (size_t)(a.key0 + (t) * 64) * (size_t)(a.kpitch * 2); \
        glds16(kb_ + koff1, (unsigned)__builtin_amdgcn_readfirstlane(lds0 + kd1 + (unsigned)((slot) * KB))); \
        glds16(kb_ + koff2, (unsigned)__builtin_amdgcn_readfirstlane(lds0 + (has2 ? kd2 + (unsigned)((slot) * KB) : (unsigned)DUM))); } while (0)
#define ATT_DMAV(t, slot) do { const char* vb_ = (const char*)a.V + (size_t)(a.key0 + (t) * 64) * (size_t)(a.vpitch * 2); \
        glds16(vb_ + voff, (unsigned)__builtin_amdgcn_readfirstlane(lds0 + vd + (unsigned)((slot) * 8192))); } while (0)
#define ATT_WAITBAR(n) asm volatile("s_waitcnt vmcnt(" #n ") lgkmcnt(0)\n\ts_barrier" ::: "memory")
    bf16x8 qf[ND];
#pragma unroll
    for (int d0 = 0; d0 < ND; ++d0) qf[d0] = *(const bf16x8*)(a.Q + (size_t)qrow * a.qpitch + d0 * 16 + hi * 8);
    ATT_DMAK(0, 0); ATT_DMAV(0, 0); ATT_DMAK(ATT_CL(1), 1); ATT_DMAK(ATT_CL(2), 2); ATT_DMAV(ATT_CL(1), 1);
#define ATT_QK(dst, slot, cinit) do { LAS const unsigned char* Kt_ = c.lds + KR + (slot) * KB; dst##A = cinit; dst##B = cinit; \
        _Pragma("unroll") for (int d0 = 0; d0 < ND; ++d0) { const bf16x8 k0_ = *(const LAS bf16x8*)(Kt_ + r32 * KP + (2 * d0 + hi) * 16), k1_ = *(const LAS bf16x8*)(Kt_ + (32 + r32) * KP + (2 * d0 + hi) * 16); \
            dst##A = MFMA32(k0_, qf[d0], dst##A); dst##B = MFMA32(k1_, qf[d0], dst##B); } } while (0)
    ATT_WAITBAR(6);
    f32x16 sCA, sCB, sNA, sNB, negm; const f32x16 zero16 = (f32x16){};
    float m_run, l_run = 0.f, l_run2 = 0.f; f32x16 o[2]; o[0] = (f32x16){}; o[1] = (f32x16){};
    if (FIXED) {
        m_run = 0.f; negm = zero16;
        ATT_QK(sC, 0, zero16);
    } else {
        ATT_QK(sC, 0, zero16);
        const float mx = rowmax32(sCA, sCB); m_run = mx;
#pragma unroll
        for (int r = 0; r < 16; ++r) { sCA[r] -= mx; sCB[r] -= mx; negm[r] = -mx; } }
    ATT_WAITBAR(3);
    const int qrw = (c.lane & 15) >> 2, p = c.lane & 3, ebit = (c.lane >> 4) & 1;
    const unsigned vb0 = (unsigned)(4 * hi + qrw) * 128u + (unsigned)((32 * ebit + 8 * p) ^ (((qrw >> 1) & 1) * 64));
    const unsigned kfb = (unsigned)(r32 * KP + hi * 16);
    int r0 = 0, r1 = 1, r2 = 2;
    constexpr int NQ = 2 * ND, E1PER = FIXED ? 2 : 3, ELIM1 = FIXED ? 2 * NQ : (MODE == 0 ? 24 : 32), E2PER = FIXED ? (MODE == 0 ? 3 : 2) : 2;
#define SB() __builtin_amdgcn_sched_barrier(0)
#define ATT_STEP(SC, SN, t_) do { \
        ATT_DMAK(ATT_CL((t_) + 3), r0); ATT_DMAV(ATT_CL((t_) + 2), r2); \
        LAS const unsigned char* Kt_ = c.lds + KR + r1 * KB + kfb; LAS const unsigned char* Vt_ = c.lds + VR + r0 * 8192; \
        bf16x8 kf[NQ]; s16x4 va[8], vb[8]; u32x4 pw[4]; float psa = 0.f, psb = 0.f, ma = 0.f, mb = 0.f; int edone = 0, cdone = 0, mdone = 0; \
        kf[0] = *(const LAS bf16x8*)(Kt_); kf[1] = *(const LAS bf16x8*)(Kt_ + 32 * KP); \
        SB(); \
        _Pragma("unroll") for (int i = 0; i < NQ; ++i) { \
            if (i + 2 < NQ) kf[i + 2] = *(const LAS bf16x8*)(Kt_ + ((i + 2) & 1) * 32 * KP + ((i + 2) >> 1) * 32); \
            if (i + 2 == NQ) { va[0] = ldtr(Vt_ + vb0); vb[0] = ldtr(Vt_ + vb0 + 1024); } \
            if (i + 1 == NQ) { va[1] = ldtr(Vt_ + (vb0 ^ 64u)); vb[1] = ldtr(Vt_ + (vb0 ^ 64u) + 1024); } \
            if (i & 1) SN##B = MFMA32(kf[i], qf[i >> 1], i < 2 ? (FIXED ? zero16 : negm) : SN##B); else SN##A = MFMA32(kf[i], qf[i >> 1], i < 2 ? (FIXED ? zero16 : negm) : SN##A); \
            _Pragma("unroll") for (int k_ = 0; k_ < E1PER; ++k_) if (edone < ELIM1) { \
                if (edone < 16) { SC##A[edone & 15] = fexp2(SC##A[edone & 15]); if (edone & 1) psb += SC##A[edone & 15]; else psa += SC##A[edone & 15]; } \
                else            { SC##B[edone & 15] = fexp2(SC##B[edone & 15]); if (edone & 1) psb += SC##B[edone & 15]; else psa += SC##B[edone & 15]; } ++edone; } \
            _Pragma("unroll") for (int k_ = 0; k_ < 2; ++k_) if (i >= 3 && cdone < 16 && 2 * cdone + 1 < edone) { const int g_ = cdone >> 2, q_ = cdone & 3, e_ = 8 * (g_ & 1) + 2 * q_; \
                pw[g_][q_] = g_ < 2 ? pk2(SC##A[e_], SC##A[e_ + 1]) : pk2(SC##B[e_], SC##B[e_ + 1]); ++cdone; } \
            asm volatile("" : "+v"(psa), "+v"(psb)); \
            SB(); } \
        _Pragma("unroll") for (int j = 0; j < 8; ++j) { const int g_ = j >> 1, eb_ = j & 1; \
            if (j + 2 < 8) { LAS const unsigned char* vp_ = Vt_ + (vb0 ^ (unsigned)(64 * ((j + 2) & 1))) + ((j + 2) >> 1) * 2048; va[j + 2] = ldtr(vp_); vb[j + 2] = ldtr(vp_ + 1024); } \
            _Pragma("unroll") for (int k_ = 0; k_ < E2PER; ++k_) if (edone < 32) { \
                SC##B[edone & 15] = fexp2(SC##B[edone & 15]); if (edone & 1) psb += SC##B[edone & 15]; else psa += SC##B[edone & 15]; ++edone; } \
            _Pragma("unroll") for (int k_ = 0; k_ < 4; ++k_) if (cdone < 16 && 2 * cdone + 1 < edone && (cdone >> 2) <= g_ + 1) { const int g2_ = cdone >> 2, q_ = cdone & 3, e_ = 8 * (g2_ & 1) + 2 * q_; \
                pw[g2_][q_] = g2_ < 2 ? pk2(SC##A[e_], SC##A[e_ + 1]) : pk2(SC##B[e_], SC##B[e_ + 1]); ++cdone; } \
            { const bf16x8 af_ = (bf16x8){va[j][0], va[j][1], va[j][2], va[j][3], vb[j][0], vb[j][1], vb[j][2], vb[j][3]}; \
              o[eb_] = MFMA32(af_, __builtin_bit_cast(bf16x8, pw[g_]), o[eb_]); } \
            _Pragma("unroll") for (int k_ = 0; k_ < 3; ++k_) if (!FIXED && j >= 2 && mdone < 15) {   \
                if (mdone == 0) ma = max3f(SN##A[0], SN##A[1], SN##B[0]); else if (mdone == 1) mb = max3f(SN##A[2], SN##A[3], SN##B[1]); else if (mdone == 2) ma = max3f(ma, SN##B[2], SN##B[3]); \
                else { const int r_ = 4 + 4 * ((mdone - 3) >> 2), w_ = (mdone - 3) & 3; \
                    if (w_ == 0) ma = max3f(ma, SN##A[r_], SN##A[r_ + 1]); else if (w_ == 1) mb = max3f(mb, SN##A[r_ + 2], SN##A[r_ + 3]); else if (w_ == 2) ma = max3f(ma, SN##B[r_], SN##B[r_ + 1]); else mb = max3f(mb, SN##B[r_ + 2], SN##B[r_ + 3]); } \
                ++mdone; } \
            asm volatile("" : "+v"(psa), "+v"(psb)); \
            SB(); } \
        l_run += psa; l_run2 += psb; \
        float mx_ = 0.f; if (!FIXED) { mx_ = fmaxf(ma, mb); auto rr_ = __builtin_amdgcn_permlane32_swap(__float_as_uint(mx_), __float_as_uint(mx_), false, false); mx_ = fmaxf(__uint_as_float(rr_[0]), __uint_as_float(rr_[1])); } \
        ATT_WAITBAR(3); \
        { const int tmp_ = r0; r0 = r1; r1 = r2; r2 = tmp_; } \
        if (!FIXED && __builtin_expect(__any(mx_ > THR), 0)) { const float dl = fmaxf(mx_, 0.f); const float al = fexp2(-dl); m_run += dl; l_run *= al; l_run2 *= al; o[0] = o[0] * al; o[1] = o[1] * al; \
            _Pragma("unroll") for (int r = 0; r < 16; ++r) { SN##A[r] -= dl; SN##B[r] -= dl; negm[r] -= dl; } } \
        if (!FIXED) asm volatile("" : "+v"(negm)); \
    } while (0)
    for (int t = 0; t < a.ntiles; t += 2) {
        ATT_STEP(sC, sN, t);
        ATT_STEP(sN, sC, t + 1);
    }
    l_run += l_run2;
#undef SB
    ATT_WAITBAR(0);
    l_run += xhalf(l_run); const float il = 1.f / l_run;
#pragma unroll
    for (int eb = 0; eb < 2; ++eb)
#pragma unroll
        for (int rq = 0; rq < 4; ++rq) { const int e0 = 32 * eb + 8 * rq + 4 * hi;
            u32x2 w; w.x = pk2(o[eb][4 * rq] * il, o[eb][4 * rq + 1] * il); w.y = pk2(o[eb][4 * rq + 2] * il, o[eb][4 * rq + 3] * il);
            *(u32x2*)(a.O + (size_t)qrow * a.opitch + e0) = w; }
#undef ATT_STEP
#undef ATT_CL
#undef ATT_DMAK
#undef ATT_DMAV
#undef ATT_WAITBAR
#undef ATT_QK
}
template <int MODE>
__device__ __forceinline__ void att_qprep(const AttnArgs& a, const float2* T, int qrow, int hi, bf16x8 (&qf)[MODE == 0 ? 4 : 6]) {
    constexpr int DQ = MODE == 0 ? 64 : 96, ND = DQ / 16; constexpr float SCALE = (MODE == 0 ? 0.125f : 0.10206207261596575f) * LOG2E;
    float x[ND][8];
#pragma unroll
    for (int d0 = 0; d0 < ND; ++d0) { const u32x4 w = *(const u32x4*)(a.Q + (size_t)qrow * a.qpitch + d0 * 16 + hi * 8);
#pragma unroll
        for (int k = 0; k < 4; ++k) { x[d0][2 * k] = bflo(w[k]); x[d0][2 * k + 1] = bfhi(w[k]); } }
    float ss = 0.f;
#pragma unroll
    for (int d0 = 0; d0 < 4; ++d0)
#pragma unroll
        for (int k = 0; k < 8; ++k) ss += x[d0][k] * x[d0][k];
    ss += xhalf(ss); const float rs = rsqrtf(ss * (1.f / 64.f) + EPS);
#pragma unroll
    for (int d0 = 0; d0 < 4; ++d0)
#pragma unroll
        for (int k = 0; k < 8; ++k) x[d0][k] *= rs * a.g1[d0 * 16 + hi * 8 + k];
    const int qr = a.rope ? qrow : 0, pr = qr / 64, pc = qr % 64;
    if (MODE == 0) {
#pragma unroll
        for (int d0 = 0; d0 < 4; ++d0)
#pragma unroll
            for (int k = 0; k < 4; ++k) { const int i = 8 * d0 + 4 * hi + k; float2 cs = T[(i < 16 ? pr : pc) * 16 + (i & 15)]; if (!a.rope) cs = make_float2(1.f, 0.f);
                const float a0 = x[d0][2 * k] * cs.x - x[d0][2 * k + 1] * cs.y, b0 = x[d0][2 * k] * cs.y + x[d0][2 * k + 1] * cs.x; x[d0][2 * k] = a0; x[d0][2 * k + 1] = b0; } }
    else { float s2 = 0.f;
#pragma unroll
        for (int d0 = 4; d0 < ND; ++d0)
#pragma unroll
            for (int k = 0; k < 8; ++k) s2 += x[d0][k] * x[d0][k];
        s2 += xhalf(s2); const float r2 = rsqrtf(s2 * (1.f / 32.f) + EPS);
#pragma unroll
        for (int d0 = 4; d0 < ND; ++d0) {
#pragma unroll
            for (int k = 0; k < 8; ++k) x[d0][k] *= r2 * a.g2[(d0 - 4) * 16 + hi * 8 + k];
#pragma unroll
            for (int k = 0; k < 4; ++k) { const int i = 8 * (d0 - 4) + 4 * hi + k; rope_pair(x[d0][2 * k], x[d0][2 * k + 1], T, i < 8 ? pr : pc, 2 * (i & 7)); } } }
#pragma unroll
    for (int d0 = 0; d0 < ND; ++d0) { u32x4 w;
#pragma unroll
        for (int k = 0; k < 4; ++k) w[k] = pk2(x[d0][2 * k] * SCALE, x[d0][2 * k + 1] * SCALE);
        qf[d0] = __builtin_bit_cast(bf16x8, w); }
}
template <int MODE>
__device__ __forceinline__ void ph_qprep(const Ctx& c, bf16_t* Qbase, int pitch, int nrows, const float* g1, const float* g2, const float2* T) {
    constexpr int DQ = MODE == 0 ? 64 : 96, ND = DQ / 16;
    const int r32 = c.lane & 31, hi = c.lane >> 5;
    for (int task = c.b * 8 + c.wid; task < (nrows / 32) * 8; task += gridDim.x * 8) { const int rb = task >> 3, h = task & 7; const int qrow = rb * 32 + r32;
        AttnArgs a{Qbase + h * DQ, pitch, nullptr, 0, nullptr, 0, nullptr, 0, 0, 0, 0, qrow < SEQ, g1, g2};
        bf16x8 qf[ND]; att_qprep<MODE>(a, T, qrow, hi, qf);
#pragma unroll
        for (int d0 = 0; d0 < ND; ++d0) *(bf16x8*)(Qbase + (size_t)qrow * pitch + h * DQ + d0 * 16 + hi * 8) = qf[d0]; }
}
template <int MODE>
__device__ __forceinline__ void attn64_unit(const Ctx& c, const AttnArgs& a, int rows_valid) {
    constexpr int DQ = MODE == 0 ? 64 : 96, ND = DQ / 16, KP = DQ * 2 + 16, KB = 64 * KP, NKB = KB / 1024, CPR = DQ / 8;
    constexpr int KR = 0, VR = 3 * KB, DUM = VR + 3 * 8192;
    const int r32 = c.lane & 31, hi = c.lane >> 5; const int rl = c.wid * 64 + r32; const bool live = rl < rows_valid;
    const int qrowA = a.q0 + (live ? rl : r32), qrowB = qrowA + 32;
    bf16x8 qfA[ND], qfB[ND];
#pragma unroll
    for (int d0 = 0; d0 < ND; ++d0) { qfA[d0] = *(const bf16x8*)(a.Q + (size_t)qrowA * a.qpitch + d0 * 16 + hi * 8); qfB[d0] = *(const bf16x8*)(a.Q + (size_t)qrowB * a.qpitch + d0 * 16 + hi * 8); }
#pragma unroll
    for (int d0 = 0; d0 < ND; ++d0) asm volatile("" :: "v"(qfA[d0]), "v"(qfB[d0]));
    unsigned koff1, koff2, voff; const bool has2 = (8 + c.wid) < NKB;
    { const int o1 = 1024 * c.wid + 16 * c.lane, row1 = o1 / KP, ch1 = (o1 % KP) / 16; koff1 = (unsigned)(row1 * a.kpitch * 2 + (ch1 < CPR ? ch1 : 0) * 16);
      const int o2 = 1024 * (8 + c.wid) + 16 * c.lane, row2 = o2 / KP, ch2 = (o2 % KP) / 16; koff2 = has2 ? (unsigned)(row2 * a.kpitch * 2 + (ch2 < CPR ? ch2 : 0) * 16) : koff1;
      const int vrow = 8 * c.wid + (c.lane >> 3), pc = c.lane & 7, lc = pc ^ (4 * ((vrow >> 1) & 1)); voff = (unsigned)(vrow * a.vpitch * 2 + lc * 16); }
    const unsigned kd1 = (unsigned)(KR + 1024 * c.wid), kd2 = has2 ? (unsigned)(KR + 1024 * (8 + c.wid)) : 0u, vd = (unsigned)(VR + 1024 * c.wid);
    const int ntm1 = a.ntiles - 1; const unsigned lds0 = (unsigned)(uintptr_t)c.lds;
#define A64_CL(x) ((x) < ntm1 ? (x) : ntm1)
#define A64_DMAK(t, slot) do { const char* kb_ = (const char*)a.K + (size_t)(a.key0 + (t) * 64) * (size_t)(a.kpitch * 2); \
        glds16(kb_ + koff1, (unsigned)__builtin_amdgcn_readfirstlane(lds0 + kd1 + (unsigned)((slot) * KB))); \
        glds16(kb_ + koff2, (unsigned)__builtin_amdgcn_readfirstlane(lds0 + (has2 ? kd2 + (unsigned)((slot) * KB) : (unsigned)DUM))); } while (0)
#define A64_DMAV(t, slot) do { const char* vb_ = (const char*)a.V + (size_t)(a.key0 + (t) * 64) * (size_t)(a.vpitch * 2); \
        glds16(vb_ + voff, (unsigned)__builtin_amdgcn_readfirstlane(lds0 + vd + (unsigned)((slot) * 8192))); } while (0)
#define A64_WAITBAR(n) asm volatile("s_waitcnt vmcnt(" #n ") lgkmcnt(0)\n\ts_barrier" ::: "memory")
    A64_DMAK(0, 0); A64_DMAV(0, 0); A64_DMAK(A64_CL(1), 1); A64_DMAV(A64_CL(1), 1);
    A64_WAITBAR(3);
    f32x16 oA[2], oB[2]; oA[0] = (f32x16){}; oA[1] = (f32x16){}; oB[0] = (f32x16){}; oB[1] = (f32x16){};
    float lA = 0.f, lA2 = 0.f, lB = 0.f, lB2 = 0.f;
    const int qrw = (c.lane & 15) >> 2, p = c.lane & 3, ebit = (c.lane >> 4) & 1;
    const unsigned vb0 = (unsigned)(4 * hi + qrw) * 128u + (unsigned)((32 * ebit + 8 * p) ^ (((qrw >> 1) & 1) * 64));
    const unsigned kfb = (unsigned)(r32 * KP + hi * 16);
    int r0 = 0, r2 = 2;
    for (int t = 0; t < a.ntiles; ++t) {
        LAS const unsigned char* Kt = c.lds + KR + r0 * KB + kfb; LAS const unsigned char* Vt = c.lds + VR + r0 * 8192;
        const bf16x8 kp0 = *(const LAS bf16x8*)(Kt), kp1 = *(const LAS bf16x8*)(Kt + 32 * KP);
        A64_DMAK(A64_CL(t + 2), r2); A64_DMAV(A64_CL(t + 2), r2);
        f32x16 sA0 = (f32x16){}, sA1 = (f32x16){}, sB0 = (f32x16){}, sB1 = (f32x16){};
#pragma unroll
        for (int d0 = 0; d0 < ND; ++d0) { const bf16x8 k0 = d0 == 0 ? kp0 : *(const LAS bf16x8*)(Kt + d0 * 32), k1 = d0 == 0 ? kp1 : *(const LAS bf16x8*)(Kt + 32 * KP + d0 * 32);
            sA0 = MFMA32(k0, qfA[d0], sA0); sB0 = MFMA32(k0, qfB[d0], sB0); sA1 = MFMA32(k1, qfA[d0], sA1); sB1 = MFMA32(k1, qfB[d0], sB1); }
        u32x4 pwA[4], pwB[4];
#pragma unroll
        for (int r = 0; r < 16; r += 2) { sA0[r] = fexp2(sA0[r]); sA0[r + 1] = fexp2(sA0[r + 1]); lA += sA0[r]; lA2 += sA0[r + 1]; pwA[r >> 3][(r >> 1) & 3] = pk2(sA0[r], sA0[r + 1]); }
#pragma unroll
        for (int r = 0; r < 16; r += 2) { sB0[r] = fexp2(sB0[r]); sB0[r + 1] = fexp2(sB0[r + 1]); lB += sB0[r]; lB2 += sB0[r + 1]; pwB[r >> 3][(r >> 1) & 3] = pk2(sB0[r], sB0[r + 1]); }
#pragma unroll
        for (int r = 0; r < 16; r += 2) { sA1[r] = fexp2(sA1[r]); sA1[r + 1] = fexp2(sA1[r + 1]); lA += sA1[r]; lA2 += sA1[r + 1]; pwA[2 + (r >> 3)][(r >> 1) & 3] = pk2(sA1[r], sA1[r + 1]); }
#pragma unroll
        for (int r = 0; r < 16; r += 2) { sB1[r] = fexp2(sB1[r]); sB1[r + 1] = fexp2(sB1[r + 1]); lB += sB1[r]; lB2 += sB1[r + 1]; pwB[2 + (r >> 3)][(r >> 1) & 3] = pk2(sB1[r], sB1[r + 1]); }
#pragma unroll
        for (int g = 0; g < 4; ++g)
#pragma unroll
            for (int eb = 0; eb < 2; ++eb) { LAS const unsigned char* vp = Vt + (vb0 ^ (unsigned)(64 * eb)) + g * 2048;
                const s16x4 a0 = ldtr(vp), a1 = ldtr(vp + 1024);
                const bf16x8 af = (bf16x8){a0[0], a0[1], a0[2], a0[3], a1[0], a1[1], a1[2], a1[3]};
                oA[eb] = MFMA32(af, __builtin_bit_cast(bf16x8, pwA[g]), oA[eb]); oB[eb] = MFMA32(af, __builtin_bit_cast(bf16x8, pwB[g]), oB[eb]); }
        A64_WAITBAR(3);
        r0 = r0 == 2 ? 0 : r0 + 1; r2 = r0 == 0 ? 2 : r0 - 1;
    }
    A64_WAITBAR(0);
    lA += lA2; lB += lB2; lA += xhalf(lA); lB += xhalf(lB); const float ilA = 1.f / lA, ilB = 1.f / lB;
    if (live) {
#pragma unroll
        for (int eb = 0; eb < 2; ++eb)
#pragma unroll
            for (int rq = 0; rq < 4; ++rq) { const int e0 = 32 * eb + 8 * rq + 4 * hi;
                u32x2 w; w.x = pk2(oA[eb][4 * rq] * ilA, oA[eb][4 * rq + 1] * ilA); w.y = pk2(oA[eb][4 * rq + 2] * ilA, oA[eb][4 * rq + 3] * ilA);
                *(u32x2*)(a.O + (size_t)qrowA * a.opitch + e0) = w;
                u32x2 v; v.x = pk2(oB[eb][4 * rq] * ilB, oB[eb][4 * rq + 1] * ilB); v.y = pk2(oB[eb][4 * rq + 2] * ilB, oB[eb][4 * rq + 3] * ilB);
                *(u32x2*)(a.O + (size_t)qrowB * a.opitch + e0) = v; } }
#undef A64_CL
#undef A64_DMAK
#undef A64_DMAV
#undef A64_WAITBAR
}
}
namespace mk {
constexpr int NPH = 22;
constexpr int ROWTAB_OFF = 131072, BARW_OFF = 131072 + 16384, LDS_BYTES = BARW_OFF + 64;
#ifndef MK_PER_PHASE
#define MK_PER_PHASE 0
#endif

__global__ void __launch_bounds__(512, 2) mk_fwd(Args A) {
    extern __shared__ __attribute__((aligned(16))) unsigned char smem[];
    Ctx c; c.a = &A; c.lds = (LAS unsigned char*)smem; c.tid = threadIdx.x; c.lane = c.tid & 63; c.wid = __builtin_amdgcn_readfirstlane(c.tid >> 6); c.b = blockIdx.x;
    if (c.tid == 0) *(LAS u32x4*)(c.lds + BARW_OFF) = (u32x4){0u, 0u, 0u, 0u};
    __syncthreads();
    XcdBarrier bar; bar.bar = WSP(unsigned, WS_BAR); bar.x = 0; bar.st = (volatile LAS unsigned*)(c.lds + BARW_OFF);
    if (A.ph_hi - A.ph_lo > 1) bar = xcd_barrier_post(WSP(unsigned, WS_BAR), (volatile LAS unsigned*)(c.lds + BARW_OFF));
#ifdef MK_ONLY
#define IN(k) ((k) == MK_ONLY)
#else
#define IN(k) (A.ph_lo <= (k) && (k) < A.ph_hi)
#endif
#ifndef MK_DUPMASK
#define MK_DUPMASK 0u
#endif
#define REPS(k) for (int rep_ = 0; rep_ < 1 + (int)((MK_DUPMASK >> (k)) & 1u); ++rep_)
#define SEAM(k) do { if (IN(k) && IN((k) + 1)) xcd_barrier(bar); } while (0)
    const int G = gridDim.x;
    float* mod0l = WSP(float, WS_MOD); float* mod0c = mod0l + 6144; float* mod1l = mod0l + 2 * 6144; float* mod1c = mod0l + 3 * 6144;
    float* ctxs = WSP(float, WS_CTXS);

    if (IN(0)) REPS(0) { ph_rope_table(A, c); ph_ada(A, c); }
    const bool flag01 = IN(0) && IN(1);
    if (flag01) ada_signal(A, c);
    if (IN(1)) REPS(1) { ph_convert(A, c); if (flag01) ada_wait(A, c); ph_modulate<true, false>(A, c, A.in[0], A.in[2], A.in[6], mod0l, mod0c, 0, 1); }
    SEAM(1);
    if (IN(2)) REPS(2) { pg8::Gemm g{WSP(bf16_t, WS_XN), WSP(bf16_t, WS_W0IN), 1024, 1024, nullptr, 1024}; pg8::StaticOrder S; S.init(65, 11, G, c.b);
        pg8::EpiStore E{WSP(bf16_t, WS_P0), 2816}; pg8::gemm_phase<pg8::EpiStore, pg8::StaticOrder, true>(c.lds, g, S, E); }
    SEAM(2);
    if (IN(3)) REPS(3) { ph_ret1(A, c); ph_qprep<0>(c, WSP(bf16_t, WS_P0) + 2048, 2816, ROWS, A.in[10], nullptr, WSP(float2, WS_ROPE)); ph_kprep0(A, c); }
    SEAM(3);
    if (IN(4)) REPS(4) ph_retscan(A, c);
    SEAM(4);
    if (IN(5)) REPS(5) {
        for (int rr_ = 0; rr_ < 1 + (int)((MK_DUPMASK >> 22) & 1u); ++rr_) for (int u = c.b; u < NCHUNK * 4; u += G) ph_ret2_unit(A, c, u);
        const bf16_t* P0 = WSP(bf16_t, WS_P0);
        const float sb0 = 1.02f * sqrtf(gain_sq(A.in[10], 64, c.lane) * gain_sq(A.in[11], 64, c.lane)) * 0.125f * LOG2E; const bool fix0 = sb0 < 40.f;
        if (fix0) { { const int head = c.b & 7, qb = c.b >> 3;
                AttnArgs a{P0 + 2048 + head * 64, 2816, WSP(bf16_t, WS_KP) + (head >> 2) * 64, 128, P0 + 2688 + (head >> 2) * 64, 2816, WSP(bf16_t, WS_CAT) + 512 + head * 64, 1024, qb * 512, 0, 260, true, A.in[10], nullptr};
                attn64_unit<0>(c, a, 512); }
            if (c.b >= 8 && c.b < 16) { const int head = c.b - 8;
                AttnArgs a{P0 + 2048 + head * 64, 2816, WSP(bf16_t, WS_KP) + (head >> 2) * 64, 128, P0 + 2688 + (head >> 2) * 64, 2816, WSP(bf16_t, WS_CAT) + 512 + head * 64, 1024, SEQ, SEQ, 4, false, A.in[10], nullptr};
                attn64_unit<0>(c, a, 256); }
        } else {
        for (int i = 0; i < 2; ++i) { const int head = c.b & 7, qb = (c.b >> 3) + 32 * i;
            AttnArgs a{P0 + 2048 + head * 64, 2816, WSP(bf16_t, WS_KP) + (head >> 2) * 64, 128, P0 + 2688 + (head >> 2) * 64, 2816, WSP(bf16_t, WS_CAT) + 512 + head * 64, 1024, qb * 256, 0, 260, true, A.in[10], nullptr};
            attn_unit<0, false>(c, a, sb0); }
        if (c.b >= 8 && c.b < 16) { const int head = c.b - 8;
            AttnArgs a{P0 + 2048 + head * 64, 2816, WSP(bf16_t, WS_KP) + (head >> 2) * 64, 128, P0 + 2688 + (head >> 2) * 64, 2816, WSP(bf16_t, WS_CAT) + 512 + head * 64, 1024, SEQ, SEQ, 4, false, A.in[10], nullptr};
            attn_unit<0, false>(c, a, sb0); }
        }
    }
    SEAM(5);
    if (IN(6)) REPS(6) { for (int rr_ = 0; rr_ < 1 + (int)((MK_DUPMASK >> 23) & 1u); ++rr_) ctx_gemm_resid(c, WSP(bf16_t, WS_CAT) + (size_t)SEQ * 1024, 1024, WSP(bf16_t, WS_W0OUT), 1024, A.in[2], ctxs, mod0c + 2 * DM);
        pg8::Gemm g{WSP(bf16_t, WS_CAT), WSP(bf16_t, WS_W0OUT), 1024, 1024, nullptr, 1024}; pg8::StaticOrder S; S.init(64, 4, G, c.b);
        pg8::EpiResidB E{A.in[0], nullptr, WSP(bf16_t, WS_XB), mod0l + 2 * DM, 1.f}; pg8::gemm_phase<pg8::EpiResidB, pg8::StaticOrder, false>(c.lds, g, S, E); }
    SEAM(6);
    if (IN(7)) REPS(7) ph_modulate<true, false, true>(A, c, (const float*)WSP(bf16_t, WS_XB), ctxs, A.in[7], mod0l, mod0c, 3, 4);
    SEAM(7);
    if (IN(8)) REPS(8) { pg8::Gemm g{WSP(bf16_t, WS_XN), WSP(bf16_t, WS_W013), 1024, 1024, nullptr, 1024}; pg8::StaticOrder S; S.init(65, 22, G, c.b);
        pg8::EpiSwiglu E{WSP(bf16_t, WS_P0), 2816, 1.f}; pg8::gemm_phase<pg8::EpiSwiglu, pg8::StaticOrder, true>(c.lds, g, S, E); }
    SEAM(8);
    if (IN(9)) REPS(9) { ctx_gemm_resid(c, WSP(bf16_t, WS_P0) + (size_t)SEQ * 2816, 2816, WSP(bf16_t, WS_W02), 2816, ctxs, ctxs, mod0c + 5 * DM);
        pg8::Gemm g{WSP(bf16_t, WS_P0), WSP(bf16_t, WS_W02), 2816, 2816, nullptr, 2816}; pg8::StaticOrder S; S.init(64, 4, G, c.b);
        pg8::EpiResidB E{nullptr, WSP(bf16_t, WS_XB), WSP(bf16_t, WS_XB), mod0l + 5 * DM, 1.f}; pg8::gemm_phase<pg8::EpiResidB, pg8::StaticOrder, false>(c.lds, g, S, E); }
    SEAM(9);
    if (IN(10)) REPS(10) ph_modulate<true, false, true>(A, c, (const float*)WSP(bf16_t, WS_XB), ctxs, A.in[18], mod1l, mod1c, 0, 1);
    SEAM(10);
    if (IN(11)) REPS(11) { pg8::Gemm g{WSP(bf16_t, WS_XN), WSP(bf16_t, WS_W1IN), 1024, 1024, nullptr, 1024}; pg8::StaticOrder S; S.init(65, 3, G, c.b);
        pg8::EpiStore E{WSP(bf16_t, WS_P1), 768}; pg8::gemm_phase<pg8::EpiStore, pg8::StaticOrder, true>(c.lds, g, S, E); }
    SEAM(11);
    if (IN(12)) REPS(12) ph_prep1a(A, c);
    SEAM(12);
    if (IN(13)) REPS(13) {
        { pg8::Gemm g{WSP(bf16_t, WS_P1), WSP(bf16_t, WS_W1UQ), 384, 768, nullptr, 384}; pg8::StaticOrder S; S.init(64, 3, G, c.b);
          pg8::EpiStore E{WSP(bf16_t, WS_Q1), 768}; pg8::gemm_phase<pg8::EpiStore, pg8::StaticOrder, true>(c.lds, g, S, E); }
        { pg8::Gemm g{WSP(bf16_t, WS_P1) + 384, WSP(bf16_t, WS_W1UKV), 256, 768, nullptr, 256}; pg8::StaticOrder S; S.init(65, 4, G, (c.b + 64) & 255);
          pg8::EpiStore E{WSP(bf16_t, WS_KV1), 1024}; pg8::gemm_phase<pg8::EpiStore, pg8::StaticOrder, true>(c.lds, g, S, E); }
    }
    SEAM(13);
    if (IN(14)) REPS(14) { ph_qprep<1>(c, WSP(bf16_t, WS_Q1), 768, SEQ, A.in[25], A.in[26], WSP(float2, WS_ROPE)); ph_prep1b(A, c); }
    SEAM(14);
    if (IN(15)) REPS(15) {
        const float sb1 = 1.02f * sqrtf((gain_sq(A.in[25], 64, c.lane) + gain_sq(A.in[26], 32, c.lane)) * (gain_sq(A.in[27], 64, c.lane) + gain_sq(A.in[28], 32, c.lane))) * 0.10206207261596575f * LOG2E; const bool fix1 = sb1 < 40.f;
        if (fix1) { const int head = c.b & 7, qb = c.b >> 3;
            AttnArgs a{WSP(bf16_t, WS_Q1) + head * 96, 768, WSP(bf16_t, WS_K1) + head * 96, 768, WSP(bf16_t, WS_KV1) + head * 128 + 64, 1024, WSP(bf16_t, WS_O1) + head * 64, 512, qb * 512, 0, 260, true, A.in[25], A.in[26]};
            attn64_unit<1>(c, a, 512);
        } else {
        for (int i = 0; i < 2; ++i) { const int head = c.b & 7, qb = (c.b >> 3) + 32 * i;
            AttnArgs a{WSP(bf16_t, WS_Q1) + head * 96, 768, WSP(bf16_t, WS_K1) + head * 96, 768, WSP(bf16_t, WS_KV1) + head * 128 + 64, 1024, WSP(bf16_t, WS_O1) + head * 64, 512, qb * 256, 0, 260, true, A.in[25], A.in[26]};
            attn_unit<1, false>(c, a, sb1); }
        }
    }
    SEAM(15);
    if (IN(16)) REPS(16) { pg8::Gemm g{WSP(bf16_t, WS_O1), WSP(bf16_t, WS_W1OUT), 512, 512, nullptr, 512}; pg8::StaticOrder S; S.init(64, 4, G, c.b);
        pg8::EpiResidB E{nullptr, WSP(bf16_t, WS_XB), WSP(bf16_t, WS_XB), mod1l + 2 * DM, 1.f}; pg8::gemm_phase<pg8::EpiResidB, pg8::StaticOrder, false>(c.lds, g, S, E); }
    SEAM(16);
    if (IN(17)) REPS(17) ph_modulate<false, true, true>(A, c, (const float*)WSP(bf16_t, WS_XB), ctxs, A.in[19], mod1l, mod1c, 3, 4);
    SEAM(17);
    if (IN(18)) REPS(18) ph_plan(A, c);
    SEAM(18);
    if (IN(19)) REPS(19) { const int ntiles = WSP(int, WS_TILE)[255];
        pg8::MoeOrder S; S.so.init(ntiles, 28, G, c.b); S.tile_e = WSP(int, WS_TILE);
        LAS unsigned* rowtab = (LAS unsigned*)(c.lds + ROWTAB_OFF); const unsigned* rowt = WSP(unsigned, WS_ROWT);
        { pg8::Unit u; for (int i = 0; i < 16 && S.next(i, u); ++i) if (c.tid < 256) rowtab[i * 256 + c.tid] = rowt[u.pm * 256 + c.tid]; }
        __syncthreads();
        pg8::Gemm g{WSP(bf16_t, WS_XN), WSP(bf16_t, WS_WE13), 512, 512, rowtab, 512};
        pg8::EpiSwigluQ8 E{WSP(unsigned char, WS_HM), 3584, 1.f / 64.f}; pg8::gemm_phase<pg8::EpiSwigluQ8, pg8::MoeOrder, true, true>(c.lds, g, S, E); }
    SEAM(19);
    if (IN(20)) REPS(20) { const int ntiles = WSP(int, WS_TILE)[255]; const int U = ntiles * 4; int F = (U / G) * G, R = U - F; int S = R <= 18 ? 14 : 7; if (R > 36 || R == 0) { F = U; R = 0; }
        pg8::Gemm g{WSP(bf16_t, WS_HM), WSP(bf16_t, WS_WE2), 1792, 1792, nullptr, 1792};
        { const int Ks = 1792 / S; pg8::MoeDownAll S1; S1.so.init(F >> 2, 4, G, c.b); S1.tile_e = WSP(int, WS_TILE); S1.F = F; S1.R = R; S1.S = S; S1.Ks = Ks; S1.c = c.b; S1.nw = F / G; S1.ntw = 28; S1.nts = Ks / 64;
          pg8::EpiDownAll E{WSP(bf16_t, WS_Y), 1024, 1.f / 64.f, WSP(float, WS_PART)};
          pg8::gemm_phase<pg8::EpiDownAll, pg8::MoeDownAll, true, true, true>(c.lds, g, S1, E);
          if (R > 0 && c.b < R * S) moe_split_fixup(A, c, F, S); } }
    SEAM(20);
    if (IN(21)) REPS(21) ph_combine(A, c);
#undef IN
#undef SEAM
}
}

extern "C" void kernel_launch(void* const* d_in, const int* in_sizes, int n_in, void* d_out, int out_size, void* d_ws, size_t ws_size, hipStream_t stream) {
    static int ready = 0;
    if (!ready) {
        if (hipFuncSetAttribute((const void*)mk::mk_fwd, hipFuncAttributeMaxDynamicSharedMemorySize, mk::LDS_BYTES) != hipSuccess) { fprintf(stderr, "hipFuncSetAttribute failed\n"); }
        if (ws_size < mk::WS_END) fprintf(stderr, "kernel_launch: workspace too small: %zu < %zu\n", ws_size, (size_t)mk::WS_END);
        (void)hipGetLastError();
        ready = 1;
    }
    (void)hipMemsetAsync((char*)d_ws + mk::WS_BAR, 0, 16384, stream);
    mk::Args a{};
    for (int i = 0; i < 34; ++i) a.in[i] = (const float*)d_in[i];
    a.out = (float*)d_out; a.ws = (unsigned char*)d_ws;
#if MK_PER_PHASE
    for (int k = 0; k < mk::NPH; ++k) { a.ph_lo = k; a.ph_hi = k + 1; hipLaunchKernelGGL(mk::mk_fwd, dim3(256), dim3(512), mk::LDS_BYTES, stream, a); }
#else
    a.ph_lo = 0; a.ph_hi = mk::NPH; hipLaunchKernelGGL(mk::mk_fwd, dim3(256), dim3(512), mk::LDS_BYTES, stream, a);
#endif
}
```
